# Optimizing an MI355X kernel written in HIP

```python
import jax, jax.numpy as jnp
from jax import lax
import numpy as np

D_MODEL = 2048
BATCH = 1
SEQ = 16384
DEPTH = 1

HEAD_DIM = 128
MLA_HEADS = D_MODEL // (2 * HEAD_DIM)
MOBA_HEADS = D_MODEL // (2 * HEAD_DIM)
MLA_NOPE = 128
MLA_ROPE = 64
MLA_V = 128
KV_RANK = 512
MOBA_BLOCK = 256
MOBA_TOPK = 3
Q_CHUNK = 128
MOBA_Q_CHUNK = 64
PLE_DIM = 256
ROPE_THETA = 10000.0
EPS = 1e-6
NEG = -1e30
D_FF = -(-8 * D_MODEL // (3 * 256)) * 256

MLA_Q_COLS = MLA_HEADS * (MLA_NOPE + MLA_ROPE)
MOBA_W = MOBA_HEADS * HEAD_DIM
MLA_OUT = MLA_HEADS * MLA_V
MIX_WIDTH = MLA_OUT + MOBA_W
IN_COLS = MLA_Q_COLS + KV_RANK + MLA_ROPE + 3 * MOBA_W

kernel_name = "hybrid_mla_moba_parallel_heads"


def rmsnorm(x, g):
    xf = x.astype(jnp.float32)
    y = xf * lax.rsqrt(jnp.mean(xf * xf, axis=-1, keepdims=True) + EPS)
    return (y * g.astype(jnp.float32)).astype(x.dtype)


def rope(x, pos):
    d = x.shape[-1]
    half = d // 2
    inv = ROPE_THETA ** (-(jnp.arange(half, dtype=jnp.float32) * 2.0 / d))
    ang = pos.astype(jnp.float32)[:, :, None, None] * inv
    cos, sin = jnp.cos(ang), jnp.sin(ang)
    x1 = x[..., :half].astype(jnp.float32)
    x2 = x[..., half:].astype(jnp.float32)
    return jnp.concatenate([x1 * cos - x2 * sin, x2 * cos + x1 * sin], axis=-1).astype(x.dtype)


def mla_attention(q_nope, q_pe, k_nope, k_pe, v):
    B, S, H, _ = q_nope.shape
    nc = S // Q_CHUNK
    scale = (MLA_NOPE + MLA_ROPE) ** -0.5

    def to_chunks(t):
        return t.reshape(B, nc, Q_CHUNK, H, t.shape[-1]).transpose(1, 0, 3, 2, 4)

    kn = k_nope.transpose(0, 2, 1, 3)
    vv = v.transpose(0, 2, 1, 3)
    key_idx = jnp.arange(S)

    def step(args):
        qn, qp, c = args
        s = (jnp.einsum('bhqd,bhkd->bhqk', qn, kn, preferred_element_type=jnp.float32)
             + jnp.einsum('bhqr,bkr->bhqk', qp, k_pe, preferred_element_type=jnp.float32)) * scale
        qpos = c * Q_CHUNK + jnp.arange(Q_CHUNK)
        s = jnp.where(key_idx[None, :] <= qpos[:, None], s, NEG)
        prob = jax.nn.softmax(s, axis=-1)
        return jnp.einsum('bhqk,bhkd->bhqd', prob.astype(vv.dtype), vv)

    out = lax.map(step, (to_chunks(q_nope), to_chunks(q_pe), jnp.arange(nc)))
    return out.transpose(1, 0, 3, 2, 4).reshape(B, S, H * MLA_V)


def moba_attention(q, k, v):
    B, S, H, dh = q.shape
    nb = -(-S // MOBA_BLOCK)
    pad = nb * MOBA_BLOCK - S
    scale = dh ** -0.5
    qh = q.transpose(0, 2, 1, 3)
    kp = jnp.pad(k.transpose(0, 2, 1, 3), ((0, 0), (0, 0), (0, pad), (0, 0)))
    vp = jnp.pad(v.transpose(0, 2, 1, 3), ((0, 0), (0, 0), (0, pad), (0, 0)))
    kb = kp.reshape(B, H, nb, MOBA_BLOCK, dh)
    vb = vp.reshape(B, H, nb, MOBA_BLOCK, dh)

    counts = jnp.clip(S - jnp.arange(nb) * MOBA_BLOCK, 1, MOBA_BLOCK).astype(jnp.float32)
    kmean = kb.astype(jnp.float32).sum(axis=3) / counts[:, None]
    gate = jnp.einsum('bhsd,bhnd->bhsn', qh.astype(jnp.float32), kmean)
    qblk = jnp.arange(S) // MOBA_BLOCK
    gate = jnp.where(jnp.arange(nb)[None, :] < qblk[:, None], gate, NEG)
    ksel = min(MOBA_TOPK, nb)
    _, idx = lax.top_k(gate, ksel)

    nc = S // MOBA_Q_CHUNK
    qc_all = qh.reshape(B, H, nc, MOBA_Q_CHUNK, dh).transpose(2, 0, 1, 3, 4)
    ic_all = idx.reshape(B, H, nc, MOBA_Q_CHUNK, ksel).transpose(2, 0, 1, 3, 4)
    bi = jnp.arange(B)[:, None, None, None]
    hi = jnp.arange(H)[None, :, None, None]

    def step(args):
        qc, ic, c = args
        qpos = c * MOBA_Q_CHUNK + jnp.arange(MOBA_Q_CHUNK)
        blk = (c * MOBA_Q_CHUNK) // MOBA_BLOCK
        k_sel = kb[bi, hi, ic]
        v_sel = vb[bi, hi, ic]
        s_sel = jnp.einsum('bhqd,bhqnjd->bhqnj', qc, k_sel, preferred_element_type=jnp.float32) * scale
        valid = jnp.arange(ksel)[None, :] < (qpos // MOBA_BLOCK)[:, None]
        s_sel = jnp.where(valid[:, :, None], s_sel, NEG).reshape(B, H, MOBA_Q_CHUNK, ksel * MOBA_BLOCK)
        k_own = lax.dynamic_slice_in_dim(kp, blk * MOBA_BLOCK, MOBA_BLOCK, axis=2)
        v_own = lax.dynamic_slice_in_dim(vp, blk * MOBA_BLOCK, MOBA_BLOCK, axis=2)
        s_own = jnp.einsum('bhqd,bhjd->bhqj', qc, k_own, preferred_element_type=jnp.float32) * scale
        own_pos = blk * MOBA_BLOCK + jnp.arange(MOBA_BLOCK)
        s_own = jnp.where(own_pos[None, :] <= qpos[:, None], s_own, NEG)
        prob = jax.nn.softmax(jnp.concatenate([s_sel, s_own], axis=-1), axis=-1)
        p_sel = prob[..., :ksel * MOBA_BLOCK].reshape(B, H, MOBA_Q_CHUNK, ksel, MOBA_BLOCK)
        p_own = prob[..., ksel * MOBA_BLOCK:]
        return (jnp.einsum('bhqnj,bhqnjd->bhqd', p_sel.astype(v_sel.dtype), v_sel)
                + jnp.einsum('bhqj,bhjd->bhqd', p_own.astype(v_own.dtype), v_own))

    out = lax.map(step, (qc_all, ic_all, jnp.arange(nc)))
    return out.transpose(1, 0, 3, 2, 4).reshape(B, S, H * dh)


def setup_inputs(seed: int = 0) -> dict:
    key = jax.random.key(seed)
    ks = jax.random.split(key, 20)
    f32 = jnp.float32

    def w(k, shape, fan_in):
        return jax.random.normal(k, shape, f32) * (fan_in ** -0.5)

    def gain(k, shape):
        return 1.0 + 0.02 * jax.random.normal(k, shape, f32)

    x = jax.random.normal(ks[0], (BATCH, SEQ, D_MODEL), f32)
    p = jax.random.normal(ks[1], (DEPTH, BATCH, SEQ, PLE_DIM), f32)
    positions = jnp.broadcast_to(jnp.arange(SEQ, dtype=jnp.int32)[None, :], (BATCH, SEQ))
    return {
        "x": x,
        "p": p,
        "positions": positions,
        "attn_norm": gain(ks[2], (DEPTH, D_MODEL)),
        "w_in": w(ks[3], (DEPTH, D_MODEL, IN_COLS), D_MODEL),
        "kv_norm": gain(ks[4], (DEPTH, KV_RANK)),
        "w_ukv": w(ks[5], (DEPTH, KV_RANK, MLA_HEADS * (MLA_NOPE + MLA_V)), KV_RANK),
        "w_o": w(ks[6], (DEPTH, MIX_WIDTH, D_MODEL), MIX_WIDTH),
        "ffn_norm": gain(ks[7], (DEPTH, D_MODEL)),
        "w_gate": w(ks[8], (DEPTH, D_MODEL, D_FF), D_MODEL),
        "w_up": w(ks[9], (DEPTH, D_MODEL, D_FF), D_MODEL),
        "w_down": w(ks[10], (DEPTH, D_FF, D_MODEL), D_FF),
        "ple_norm": gain(ks[11], (DEPTH, D_MODEL)),
        "w_ple_gate": w(ks[12], (DEPTH, D_MODEL, D_MODEL), D_MODEL),
        "w_ple_proj": w(ks[13], (DEPTH, PLE_DIM, D_MODEL), PLE_DIM),
        "final_norm": gain(ks[14], (D_MODEL,)),
    }


def reference(x, p, positions, attn_norm, w_in, kv_norm, w_ukv, w_o, ffn_norm,
              w_gate, w_up, w_down, ple_norm, w_ple_gate, w_ple_proj, final_norm):
    B, S, _ = x.shape
    splits = [MLA_Q_COLS, MLA_Q_COLS + KV_RANK, MLA_Q_COLS + KV_RANK + MLA_ROPE,
              MLA_Q_COLS + KV_RANK + MLA_ROPE + MOBA_W, MLA_Q_COLS + KV_RANK + MLA_ROPE + 2 * MOBA_W]
    h = x
    for i in range(DEPTH):
        a = rmsnorm(h, attn_norm[i])
        proj = a @ w_in[i]
        q_mla, c_kv, k_pe, q_mb, k_mb, v_mb = jnp.split(proj, splits, axis=-1)

        q_mla = q_mla.reshape(B, S, MLA_HEADS, MLA_NOPE + MLA_ROPE)
        q_nope, q_pe = q_mla[..., :MLA_NOPE], q_mla[..., MLA_NOPE:]
        q_pe = rope(q_pe, positions)
        k_pe = rope(k_pe[:, :, None, :], positions)[:, :, 0, :]
        kv = (rmsnorm(c_kv, kv_norm[i]) @ w_ukv[i]).reshape(B, S, MLA_HEADS, MLA_NOPE + MLA_V)
        k_nope, v_mla = kv[..., :MLA_NOPE], kv[..., MLA_NOPE:]
        out_mla = mla_attention(q_nope, q_pe, k_nope, k_pe, v_mla)

        q_mb = rope(q_mb.reshape(B, S, MOBA_HEADS, HEAD_DIM), positions)
        k_mb = rope(k_mb.reshape(B, S, MOBA_HEADS, HEAD_DIM), positions)
        v_mb = v_mb.reshape(B, S, MOBA_HEADS, HEAD_DIM)
        out_moba = moba_attention(q_mb, k_mb, v_mb)

        h = h + jnp.concatenate([out_mla, out_moba], axis=-1) @ w_o[i]

        f = rmsnorm(h, ffn_norm[i])
        h = h + (jax.nn.silu(f @ w_gate[i]) * (f @ w_up[i])) @ w_down[i]

        g = jax.nn.sigmoid(rmsnorm(h, ple_norm[i]) @ w_ple_gate[i])
        h = h + g * (p[i] @ w_ple_proj[i])
    return rmsnorm(h, final_norm)
```

```cpp
#include <hip/hip_runtime.h>
#include <cstdio>
#include <cstdint>
namespace pg8 {
#define PG8_LAS __attribute__((address_space(3)))
typedef unsigned short bf16_t;
typedef short bf16x8 __attribute__((ext_vector_type(8)));
typedef float f32x4 __attribute__((ext_vector_type(4)));
typedef unsigned u32x4 __attribute__((ext_vector_type(4)));
constexpr int BM = 256, BK = 64, HALF = 128, HTB = HALF * BK * 2  , STAGE_BYTES = 8 * HTB, NXCD = 8, WGM = 8;

__host__ __device__ __forceinline__ int lds_byte(int r, int c) { const int st = (r >> 4) * 2 + (c >> 5), rr = r & 15, cc = c & 31, ob = rr * 64 + cc * 2; return st * 1024 + (ob ^ (((ob >> 9) & 1) << 5)); }
__host__ __device__ __forceinline__ void stage_rc(int b, int& R, int& C) { const int st = b / 1024, sb = b % 1024, swz = sb ^ (((sb >> 9) & 1) << 5); R = (st >> 1) * 16 + swz / 64; C = (st & 1) * 32 + (swz % 64) / 2; }
__host__ __device__ __forceinline__ int perm32(int rho) { const int n = rho >> 4, i = rho & 15; return 8 * (i >> 2) + 4 * n + (i & 3); }

struct Unit { int pm, pn, ty; };
struct Gemm { const bf16_t* A; const bf16_t* Bt; int M, N, K; };

struct StaticOrder {
    int nM, nN, nwg, G, c;
    __host__ __device__ void init(int M, int N, int G_, int c_) { nM = M / BM; nN = N / BM; nwg = nM * nN; G = G_; c = c_; }
    __host__ __device__ bool at(long L, Unit& u) const {
        if (L >= nwg) return false;
        int wgid = (int)L; { const int q = nwg / NXCD, r = nwg % NXCD, xcd = wgid % NXCD, off = wgid / NXCD; wgid = (xcd < r ? xcd * (q + 1) : r * (q + 1) + (xcd - r) * q) + off; }
        const int nig = WGM * nN, gid = wgid / nig, fm = gid * WGM, gsz = (nM - fm) < WGM ? (nM - fm) : WGM;
        u.pm = fm + ((wgid % nig) % gsz); u.pn = (wgid % nig) / gsz; u.ty = 0; return true;
    }
    __host__ __device__ bool next(int i, Unit& u) const { return at((long)i * G + c, u); }
    __device__ __forceinline__ const char* pA(const Unit& u, const Gemm& g, size_t tstep) const { return (const char*)g.A + (size_t)u.pm * tstep; }
    __device__ __forceinline__ const char* pB(const Unit& u, const Gemm& g, size_t tstep) const { return (const char*)g.Bt + (size_t)u.pn * tstep; }
    __device__ __forceinline__ int K(const Unit&, const Gemm& g) const { return g.K; }
    __device__ __forceinline__ void a_ready(const Unit&) const {}
    __device__ __forceinline__ void done(const Unit&) const {}
};
struct DualOrder {
    StaticOrder s0, s1; int G, c; const bf16_t* A1; const bf16_t* B1;
    __host__ __device__ void init(int M0, int N0, int M1, int N1, int G_, int c_, const bf16_t* A1_, const bf16_t* B1_) { s0.init(M0, N0, G_, c_); s1.init(M1, N1, G_, c_); G = G_; c = c_; A1 = A1_; B1 = B1_; }
    __host__ __device__ bool next(int i, Unit& u) const { const long L = (long)i * G + c; if (L < s0.nwg) return s0.at(L, u); const bool ok = s1.at(L - s0.nwg, u); u.ty = 1; return ok; }
    __device__ __forceinline__ const char* pA(const Unit& u, const Gemm& g, size_t tstep) const { return (const char*)(u.ty ? A1 : g.A) + (size_t)u.pm * tstep; }
    __device__ __forceinline__ const char* pB(const Unit& u, const Gemm& g, size_t tstep) const { return (const char*)(u.ty ? B1 : g.Bt) + (size_t)u.pn * tstep; }
    __device__ __forceinline__ int K(const Unit&, const Gemm& g) const { return g.K; }
    __device__ __forceinline__ void a_ready(const Unit&) const {}
    __device__ __forceinline__ void done(const Unit&) const {}
};
struct TriOrder {
    StaticOrder s0, s1, s2; int G, c; const bf16_t *A1, *B1, *A2, *B2; int K1, K2v;
    __host__ __device__ void init(int M0, int N0, int M1, int N1, int M2, int N2, int G_, int c_, const bf16_t* A1_, const bf16_t* B1_, int K1_, const bf16_t* A2_, const bf16_t* B2_, int K2_) {
        s0.init(M0, N0, G_, c_); s1.init(M1, N1, G_, c_); s2.init(M2, N2, G_, c_); G = G_; c = c_; A1 = A1_; B1 = B1_; K1 = K1_; A2 = A2_; B2 = B2_; K2v = K2_; }
    __host__ __device__ bool full(long L, Unit& u) const { if (L < s0.nwg) return s0.at(L, u); const bool ok = s1.at(L - s0.nwg, u); u.ty = 1; return ok; }
    __host__ __device__ bool next(int i, Unit& u) const {
        const int n01 = s0.nwg + s1.nwg, rf = n01 / G, rem = n01 % G;
        if (i < rf) return full((long)i * G + c, u);
        long j;
        if (rem == 0) j = (long)(i - rf) * G + c;
        else { if (c < rem) { if (i == rf) return full((long)i * G + c, u); return false; } j = (long)(i - rf) * (G - rem) + (c - rem); }
        const bool ok = s2.at(j, u); u.ty = 2; return ok;
    }
    __device__ __forceinline__ const char* pA(const Unit& u, const Gemm& g, size_t tstep) const { return (const char*)(u.ty == 0 ? g.A : (u.ty == 1 ? A1 : A2)) + (size_t)u.pm * tstep; }
    __device__ __forceinline__ const char* pB(const Unit& u, const Gemm& g, size_t tstep) const { return (const char*)(u.ty == 0 ? g.Bt : (u.ty == 1 ? B1 : B2)) + (size_t)u.pn * tstep; }
    __device__ __forceinline__ int K(const Unit& u, const Gemm& g) const { return u.ty == 0 ? g.K : (u.ty == 1 ? K1 : K2v); }
    __device__ __forceinline__ void a_ready(const Unit&) const {}
    __device__ __forceinline__ void done(const Unit&) const {}
};
template <class E0, class E1, class E2> struct EpiTri {
    static constexpr bool PERM = true, AFTER_DRAIN = false;
    E0 e0; E1 e1; E2 e2;
    __device__ __forceinline__ void init(f32x4 (&acc)[2][2][4][2], const Unit& u, int wr, int wc, int fr, int fq) const { if (u.ty == 0) e0.init(acc, u, wr, wc, fr, fq); else if (u.ty == 1) e1.init(acc, u, wr, wc, fr, fq); else e2.init(acc, u, wr, wc, fr, fq); }
    __device__ __forceinline__ void operator()(const f32x4 (&acc)[2][2][4][2], const Unit& u, int wr, int wc, int fr, int fq) const { if (u.ty == 0) e0(acc, u, wr, wc, fr, fq); else if (u.ty == 1) e1(acc, u, wr, wc, fr, fq); else e2(acc, u, wr, wc, fr, fq); }
};
template <class E0, class E1> struct EpiDual {
    static constexpr bool PERM = true, AFTER_DRAIN = false;
    E0 e0; E1 e1;
    __device__ __forceinline__ void init(f32x4 (&acc)[2][2][4][2], const Unit& u, int wr, int wc, int fr, int fq) const { if (u.ty == 0) e0.init(acc, u, wr, wc, fr, fq); else e1.init(acc, u, wr, wc, fr, fq); }
    __device__ __forceinline__ void operator()(const f32x4 (&acc)[2][2][4][2], const Unit& u, int wr, int wc, int fr, int fq) const { if (u.ty == 0) e0(acc, u, wr, wc, fr, fq); else e1(acc, u, wr, wc, fr, fq); }
};

__device__ __forceinline__ unsigned cvt_pk_bf16(float lo, float hi) { unsigned r; asm volatile("v_cvt_pk_bf16_f32 %0, %1, %2" : "=v"(r) : "v"(lo), "v"(hi)); return r; }
typedef float f32x2 __attribute__((ext_vector_type(2)));
typedef unsigned u32x2 __attribute__((ext_vector_type(2)));
#define GASQ __attribute__((address_space(1)))
constexpr float QS_MLA = 0.07216878364870322f * 1.4426950408889634f;
constexpr float QS_MB  = 0.08838834764831845f * 1.4426950408889634f;
constexpr float EPSN = 1e-6f;
__device__ __forceinline__ u32x4 pack8(f32x4 a, f32x4 b) { u32x4 w; w.x = cvt_pk_bf16(a[0], a[1]); w.y = cvt_pk_bf16(a[2], a[3]); w.z = cvt_pk_bf16(b[0], b[1]); w.w = cvt_pk_bf16(b[2], b[3]); return w; }
__device__ __forceinline__ float sq4(f32x4 a) { return (a[0] * a[0] + a[1] * a[1]) + (a[2] * a[2] + a[3] * a[3]); }
__device__ __forceinline__ float bf2f(unsigned short h) { return __uint_as_float(((unsigned)h) << 16); }
__device__ __forceinline__ void rope8(const float* tabp, f32x4 a0, f32x4 a1, f32x4 b0, f32x4 b1, f32x4& x0, f32x4& x1, f32x4& y0, f32x4& y1) {
    const f32x4 t0 = *(const f32x4*)tabp, t1 = *(const GASQ f32x4*)(tabp + 4), t2 = *(const GASQ f32x4*)(tabp + 8), t3 = *(const GASQ f32x4*)(tabp + 12);
    x0 = (f32x4){a0[0] * t0[0] - b0[0] * t0[1], a0[1] * t0[2] - b0[1] * t0[3], a0[2] * t1[0] - b0[2] * t1[1], a0[3] * t1[2] - b0[3] * t1[3]};
    x1 = (f32x4){a1[0] * t2[0] - b1[0] * t2[1], a1[1] * t2[2] - b1[1] * t2[3], a1[2] * t3[0] - b1[2] * t3[1], a1[3] * t3[2] - b1[3] * t3[3]};
    y0 = (f32x4){b0[0] * t0[0] + a0[0] * t0[1], b0[1] * t0[2] + a0[1] * t0[3], b0[2] * t1[0] + a0[2] * t1[1], b0[3] * t1[2] + a0[3] * t1[3]};
    y1 = (f32x4){b1[0] * t2[0] + a1[0] * t2[1], b1[1] * t2[2] + a1[1] * t2[3], b1[2] * t3[0] + a1[2] * t3[1], b1[3] * t3[2] + a1[3] * t3[3]};
}
#define EPI_ZERO(acc) _Pragma("unroll") for (int a_ = 0; a_ < 2; ++a_) _Pragma("unroll") for (int b_ = 0; b_ < 2; ++b_) _Pragma("unroll") for (int m_ = 0; m_ < 4; ++m_) _Pragma("unroll") for (int n_ = 0; n_ < 2; ++n_) acc[a_][b_][m_][n_] = (f32x4){0.f, 0.f, 0.f, 0.f}
#define EPI_ROWS_BEGIN _Pragma("unroll") for (int ai = 0; ai < 2; ++ai) _Pragma("unroll") for (int m = 0; m < 4; ++m) { const int row = u.pm * BM + ai * HALF + wr * 64 + m * 16 + fr; \
        const f32x4 a0 = acc[ai][0][m][0], a1 = acc[ai][0][m][1], b0 = acc[ai][1][m][0], b1 = acc[ai][1][m][1];
#define EPI_ROWS_END }
struct EpiProj {
    static constexpr bool PERM = true, AFTER_DRAIN = false;
    __device__ __forceinline__ void init(f32x4 (&acc)[2][2][4][2], const Unit&, int, int, int, int) const { EPI_ZERO(acc); }
    bf16_t *qmla, *kmla, *ckv, *qmb, *kmb; float* ssqc; const float* tab128; const float* tab64;
    __device__ __forceinline__ void operator()(const f32x4 (&acc)[2][2][4][2], const Unit& u, int wr, int wc, int fr, int fq) const {
        asm volatile("" : "+v"(fr), "+v"(fq));
        const int t = u.pn, c8 = wc * 32 + 8 * fq;
        EPI_ROWS_BEGIN
            if (t < 4) {
                *(GASQ u32x4*)(qmla + (size_t)row * 1536 + (2 * t) * 192 + c8) = pack8(a0 * QS_MLA, a1 * QS_MLA);
                *(GASQ u32x4*)(qmla + (size_t)row * 1536 + (2 * t + 1) * 192 + c8) = pack8(b0 * QS_MLA, b1 * QS_MLA);
            } else if (t < 6) {
                const int head = 4 * (t - 4) + (c8 >> 5), i0 = c8 & 31; f32x4 x0, x1, y0, y1;
                rope8(tab64 + ((size_t)row * 32 + i0) * 2, a0, a1, b0, b1, x0, x1, y0, y1);
                *(GASQ u32x4*)(qmla + (size_t)row * 1536 + head * 192 + 128 + i0) = pack8(x0 * QS_MLA, x1 * QS_MLA);
                *(GASQ u32x4*)(qmla + (size_t)row * 1536 + head * 192 + 160 + i0) = pack8(y0 * QS_MLA, y1 * QS_MLA);
            } else if (t < 8) {
                *(GASQ u32x4*)(ckv + (size_t)row * 512 + 256 * (t - 6) + c8) = pack8(a0, a1);
                *(GASQ u32x4*)(ckv + (size_t)row * 512 + 256 * (t - 6) + 128 + c8) = pack8(b0, b1);
                float s = (sq4(a0) + sq4(a1)) + (sq4(b0) + sq4(b1)); s += __shfl_xor(s, 16); s += __shfl_xor(s, 32);
                if (fq == 0) unsafeAtomicAdd(ssqc + row, s);
            } else if (t < 16) {
                const bool isq = t < 12; const int uu = isq ? t - 8 : t - 12; const int head = 2 * uu + (c8 >> 6), i0 = c8 & 63; f32x4 x0, x1, y0, y1;
                rope8(tab128 + ((size_t)row * 64 + i0) * 2, a0, a1, b0, b1, x0, x1, y0, y1);
                bf16_t* dst = (isq ? qmb : kmb) + (size_t)row * 1024 + head * 128 + i0; const float sc = isq ? QS_MB : 1.0f;
                *(GASQ u32x4*)(dst) = pack8(x0 * sc, x1 * sc);
                *(GASQ u32x4*)(dst + 64) = pack8(y0 * sc, y1 * sc);
            } else {
                if (c8 < 32) { f32x4 x0, x1, y0, y1;
                    rope8(tab64 + ((size_t)row * 32 + c8) * 2, a0, a1, b0, b1, x0, x1, y0, y1);
                    const u32x4 w1 = pack8(x0, x1), w2 = pack8(y0, y1);
#pragma unroll
                    for (int h = 0; h < 8; ++h) { *(GASQ u32x4*)(kmla + (size_t)row * 1536 + h * 192 + 128 + c8) = w1; *(GASQ u32x4*)(kmla + (size_t)row * 1536 + h * 192 + 160 + c8) = w2; } }
            }
        EPI_ROWS_END
    }
};
template <bool SCALE> struct EpiT {
    static constexpr bool PERM = true, AFTER_DRAIN = false;
    __device__ __forceinline__ void init(f32x4 (&acc)[2][2][4][2], const Unit&, int, int, int, int) const { EPI_ZERO(acc); }
    bf16_t* O; int ldc; const float* ssq; float invn;
    __device__ __forceinline__ void operator()(const f32x4 (&acc)[2][2][4][2], const Unit& u, int wr, int wc, int fr, int fq) const {
        asm volatile("" : "+v"(fr), "+v"(fq));
        const int c8 = wc * 32 + 8 * fq, colA = u.pn * BM + c8, colB = colA + HALF;
        f32x4 sa0 = (f32x4){1.f, 1.f, 1.f, 1.f}, sa1 = sa0, sb0 = sa0, sb1 = sa0;
        if (SCALE) { sa0 = *(const GASQ f32x4*)(ssq + colA); sa1 = *(const GASQ f32x4*)(ssq + colA + 4); sb0 = *(const GASQ f32x4*)(ssq + colB); sb1 = *(const GASQ f32x4*)(ssq + colB + 4);
#pragma unroll
            for (int j = 0; j < 4; ++j) { sa0[j] = __builtin_amdgcn_rsqf(sa0[j] * invn + EPSN); sa1[j] = __builtin_amdgcn_rsqf(sa1[j] * invn + EPSN); sb0[j] = __builtin_amdgcn_rsqf(sb0[j] * invn + EPSN); sb1[j] = __builtin_amdgcn_rsqf(sb1[j] * invn + EPSN); } }
        EPI_ROWS_BEGIN
            if (SCALE) { *(GASQ u32x4*)(O + (size_t)row * ldc + colA) = pack8(a0 * sa0, a1 * sa1); *(GASQ u32x4*)(O + (size_t)row * ldc + colB) = pack8(b0 * sb0, b1 * sb1); }
            else { *(GASQ u32x4*)(O + (size_t)row * ldc + colA) = pack8(a0, a1); *(GASQ u32x4*)(O + (size_t)row * ldc + colB) = pack8(b0, b1); }
        EPI_ROWS_END
    }
};
struct EpiKnope {
    static constexpr bool PERM = true, AFTER_DRAIN = false;
    __device__ __forceinline__ void init(f32x4 (&acc)[2][2][4][2], const Unit&, int, int, int, int) const { EPI_ZERO(acc); }
    bf16_t* kmla; const float* ssqc;
    __device__ __forceinline__ void operator()(const f32x4 (&acc)[2][2][4][2], const Unit& u, int wr, int wc, int fr, int fq) const {
        asm volatile("" : "+v"(fr), "+v"(fq));
        const int c8 = wc * 32 + 8 * fq;
        EPI_ROWS_BEGIN
            const float r = __builtin_amdgcn_rsqf(ssqc[row] * (1.0f / 512.0f) + EPSN);
            *(GASQ u32x4*)(kmla + (size_t)row * 1536 + (2 * u.pn) * 192 + c8) = pack8(a0 * r, a1 * r);
            *(GASQ u32x4*)(kmla + (size_t)row * 1536 + (2 * u.pn + 1) * 192 + c8) = pack8(b0 * r, b1 * r);
        EPI_ROWS_END
    }
};
__device__ __forceinline__ void unpack8(u32x4 w, f32x4& lo, f32x4& hi) {
    lo = (f32x4){__uint_as_float(w.x << 16), __uint_as_float(w.x & 0xffff0000u), __uint_as_float(w.y << 16), __uint_as_float(w.y & 0xffff0000u)};
    hi = (f32x4){__uint_as_float(w.z << 16), __uint_as_float(w.z & 0xffff0000u), __uint_as_float(w.w << 16), __uint_as_float(w.w & 0xffff0000u)}; }
template <bool BASEF32> struct EpiRes {
    static constexpr bool PERM = true, AFTER_DRAIN = false;
    const void* base; bf16_t* hb; float* ssq;
    __device__ __forceinline__ void init(f32x4 (&acc)[2][2][4][2], const Unit& u, int wr, int wc, int fr, int fq) const {
        asm volatile("" : "+v"(fr), "+v"(fq));
        const int colA = u.pn * BM + wc * 32 + 8 * fq, colB = colA + HALF;
#pragma unroll
        for (int ai = 0; ai < 2; ++ai)
#pragma unroll
            for (int m = 0; m < 4; ++m) { const size_t o = (size_t)(u.pm * BM + ai * HALF + wr * 64 + m * 16 + fr) * 2048;
                if (BASEF32) { const float* bp = (const float*)base; acc[ai][0][m][0] = *(const GASQ f32x4*)(bp + o + colA); acc[ai][0][m][1] = *(const GASQ f32x4*)(bp + o + colA + 4); acc[ai][1][m][0] = *(const GASQ f32x4*)(bp + o + colB); acc[ai][1][m][1] = *(const GASQ f32x4*)(bp + o + colB + 4); }
                else { const bf16_t* bp = (const bf16_t*)base; unpack8(*(const GASQ u32x4*)(bp + o + colA), acc[ai][0][m][0], acc[ai][0][m][1]); unpack8(*(const GASQ u32x4*)(bp + o + colB), acc[ai][1][m][0], acc[ai][1][m][1]); } }
    }
    __device__ __forceinline__ void operator()(const f32x4 (&acc)[2][2][4][2], const Unit& u, int wr, int wc, int fr, int fq) const {
        asm volatile("" : "+v"(fr), "+v"(fq));
        const int colA = u.pn * BM + wc * 32 + 8 * fq, colB = colA + HALF;
        EPI_ROWS_BEGIN
            const size_t o = (size_t)row * 2048;
            *(GASQ u32x4*)(hb + o + colA) = pack8(a0, a1); *(GASQ u32x4*)(hb + o + colB) = pack8(b0, b1);
            float s = (sq4(a0) + sq4(a1)) + (sq4(b0) + sq4(b1)); s += __shfl_xor(s, 16); s += __shfl_xor(s, 32);
            if (fq == 0) unsafeAtomicAdd(ssq + row, s);
        EPI_ROWS_END
    }
};
struct EpiSwiglu {
    static constexpr bool PERM = true, AFTER_DRAIN = false;
    __device__ __forceinline__ void init(f32x4 (&acc)[2][2][4][2], const Unit&, int, int, int, int) const { EPI_ZERO(acc); }
    bf16_t* ff; const float* ssq;
    __device__ __forceinline__ void operator()(const f32x4 (&acc)[2][2][4][2], const Unit& u, int wr, int wc, int fr, int fq) const {
        asm volatile("" : "+v"(fr), "+v"(fq));
        const int c8 = wc * 32 + 8 * fq;
        EPI_ROWS_BEGIN
            const float r = __builtin_amdgcn_rsqf(ssq[row] * (1.0f / 2048.0f) + EPSN);
            f32x4 g0 = a0 * r, g1 = a1 * r; const f32x4 u0 = b0 * r, u1 = b1 * r;
#pragma unroll
            for (int j = 0; j < 4; ++j) { g0[j] = g0[j] * __builtin_amdgcn_rcpf(1.0f + __builtin_amdgcn_exp2f(-1.4426950408889634f * g0[j])) * u0[j]; g1[j] = g1[j] * __builtin_amdgcn_rcpf(1.0f + __builtin_amdgcn_exp2f(-1.4426950408889634f * g1[j])) * u1[j]; }
            *(GASQ u32x4*)(ff + (size_t)row * 5632 + u.pn * 128 + c8) = pack8(g0, g1);
        EPI_ROWS_END
    }
};
__device__ __forceinline__ size_t p_off(int row) { return (size_t)(row >> 8) * 1048576 + (size_t)(row & 255) * 2048; }
struct EpiP {
    static constexpr bool PERM = true, AFTER_DRAIN = false;
    bf16_t* P;
    __device__ __forceinline__ void init(f32x4 (&acc)[2][2][4][2], const Unit&, int, int, int, int) const { EPI_ZERO(acc); }
    __device__ __forceinline__ void operator()(const f32x4 (&acc)[2][2][4][2], const Unit& u, int wr, int wc, int fr, int fq) const {
        asm volatile("" : "+v"(fr), "+v"(fq));
        const int colA = u.pn * BM + wc * 32 + 8 * fq, colB = colA + HALF;
        EPI_ROWS_BEGIN
            const size_t o = p_off(row);
            *(GASQ u32x4*)(P + o + colA) = pack8(a0, a1); *(GASQ u32x4*)(P + o + colB) = pack8(b0, b1);
        EPI_ROWS_END
    }
};
struct EpiPle {
    static constexpr bool PERM = true, AFTER_DRAIN = false;
    __device__ __forceinline__ void init(f32x4 (&acc)[2][2][4][2], const Unit&, int, int, int, int) const { EPI_ZERO(acc); }
    const bf16_t* hb; bf16_t* h3b; const bf16_t* P; const float* ssq2; float* ssq3;
    __device__ __forceinline__ void operator()(const f32x4 (&acc)[2][2][4][2], const Unit& u, int wr, int wc, int fr, int fq) const {
        asm volatile("" : "+v"(fr), "+v"(fq));
        const int colA = u.pn * BM + wc * 32 + 8 * fq, colB = colA + HALF;
        EPI_ROWS_BEGIN
            const size_t o = (size_t)row * 2048; const float r = __builtin_amdgcn_rsqf(ssq2[row] * (1.0f / 2048.0f) + EPSN);
            f32x4 h0, h1, h2, h3, p0, p1, p2, p3;
            unpack8(*(const GASQ u32x4*)(hb + o + colA), h0, h1); unpack8(*(const GASQ u32x4*)(hb + o + colB), h2, h3);
            { const size_t op = p_off(row); unpack8(*(const GASQ u32x4*)(P + op + colA), p0, p1); unpack8(*(const GASQ u32x4*)(P + op + colB), p2, p3); }
#define SIG(x) __builtin_amdgcn_rcpf(1.0f + __builtin_amdgcn_exp2f(-1.4426950408889634f * r * (x)))
#pragma unroll
            for (int j = 0; j < 4; ++j) { h0[j] += SIG(a0[j]) * p0[j]; h1[j] += SIG(a1[j]) * p1[j]; h2[j] += SIG(b0[j]) * p2[j]; h3[j] += SIG(b1[j]) * p3[j]; }
#undef SIG
            *(GASQ u32x4*)(h3b + o + colA) = pack8(h0, h1); *(GASQ u32x4*)(h3b + o + colB) = pack8(h2, h3);
            float s = (sq4(h0) + sq4(h1)) + (sq4(h2) + sq4(h3)); s += __shfl_xor(s, 16); s += __shfl_xor(s, 32);
            if (fq == 0) unsafeAtomicAdd(ssq3 + row, s);
        EPI_ROWS_END
    }
};

struct PanelOrder {
    int c;
    __device__ __forceinline__ bool next(int i, Unit& u) const { if (i >= 2) return false; const int v = (c & 7) * 32 + (c >> 3); u.pm = 32 * i + (v >> 3); u.pn = v & 7; u.ty = 0; return true; }
    __device__ __forceinline__ const char* pA(const Unit& u, const Gemm& g, size_t tstep) const { return (const char*)g.A + (size_t)u.pm * tstep; }
    __device__ __forceinline__ const char* pB(const Unit& u, const Gemm& g, size_t tstep) const { return (const char*)g.Bt + (size_t)u.pn * tstep; }
    __device__ __forceinline__ int K(const Unit&, const Gemm& g) const { return g.K; }
    __device__ __forceinline__ void a_ready(const Unit&) const {}
    __device__ __forceinline__ void done(const Unit&) const {}
};
struct EpiPleFused {
    static constexpr bool PERM = true, AFTER_DRAIN = false;
    const bf16_t* hb; const bf16_t* P; const float* ssq2; float* ssq3; unsigned* pcnt; float* out; const float* gfin;
    __device__ __forceinline__ void init(f32x4 (&acc)[2][2][4][2], const Unit&, int, int, int, int) const { EPI_ZERO(acc); }
    __device__ __forceinline__ void operator()(f32x4 (&acc)[2][2][4][2], const Unit& u, int wr, int wc, int fr, int fq) const {
        asm volatile("" : "+v"(fr), "+v"(fq));
        const int colA = u.pn * BM + wc * 32 + 8 * fq, colB = colA + HALF;
#pragma unroll
        for (int ai = 0; ai < 2; ++ai)
#pragma unroll
            for (int m = 0; m < 4; ++m) { const int row = u.pm * BM + ai * HALF + wr * 64 + m * 16 + fr;
                const size_t o = (size_t)row * 2048, op = p_off(row); const float r = __builtin_amdgcn_rsqf(ssq2[row] * (1.0f / 2048.0f) + EPSN);
                f32x4 h0, h1, h2, h3, p0, p1, p2, p3;
                unpack8(*(const GASQ u32x4*)(hb + o + colA), h0, h1); unpack8(*(const GASQ u32x4*)(hb + o + colB), h2, h3);
                unpack8(*(const GASQ u32x4*)(P + op + colA), p0, p1); unpack8(*(const GASQ u32x4*)(P + op + colB), p2, p3);
#define SIG(x) __builtin_amdgcn_rcpf(1.0f + __builtin_amdgcn_exp2f(-1.4426950408889634f * r * (x)))
#pragma unroll
                for (int j = 0; j < 4; ++j) { h0[j] += SIG(acc[ai][0][m][0][j]) * p0[j]; h1[j] += SIG(acc[ai][0][m][1][j]) * p1[j]; h2[j] += SIG(acc[ai][1][m][0][j]) * p2[j]; h3[j] += SIG(acc[ai][1][m][1][j]) * p3[j]; }
#undef SIG
                acc[ai][0][m][0] = h0; acc[ai][0][m][1] = h1; acc[ai][1][m][0] = h2; acc[ai][1][m][1] = h3;
                float s = (sq4(h0) + sq4(h1)) + (sq4(h2) + sq4(h3)); s += __shfl_xor(s, 16); s += __shfl_xor(s, 32);
                if (fq == 0) unsafeAtomicAdd(ssq3 + row, s); }
        asm volatile("s_waitcnt vmcnt(0)" ::: "memory");
        unsigned* pc = pcnt + 64 * u.pm;
        if (fr == 0 && fq == 0) __hip_atomic_fetch_add(pc, 1u, __ATOMIC_RELAXED, __HIP_MEMORY_SCOPE_AGENT);
        { unsigned sp = 0; while ((unsigned)__builtin_amdgcn_readfirstlane((int)__hip_atomic_load(pc, __ATOMIC_RELAXED, __HIP_MEMORY_SCOPE_AGENT)) < 64u) { __builtin_amdgcn_s_sleep(2); if (++sp > (1u << 22)) break; } }
        asm volatile("" ::: "memory");
        const f32x4 gA0 = *(const GASQ f32x4*)(gfin + colA), gA1 = *(const GASQ f32x4*)(gfin + colA + 4), gB0 = *(const GASQ f32x4*)(gfin + colB), gB1 = *(const GASQ f32x4*)(gfin + colB + 4);
#pragma unroll
        for (int ai = 0; ai < 2; ++ai)
#pragma unroll
            for (int m = 0; m < 4; ++m) { const int row = u.pm * BM + ai * HALF + wr * 64 + m * 16 + fr; const size_t o = (size_t)row * 2048;
                const float s = __uint_as_float(__hip_atomic_load((unsigned*)(ssq3 + row), __ATOMIC_RELAXED, __HIP_MEMORY_SCOPE_AGENT));
                const float r = __builtin_amdgcn_rsqf(s * (1.0f / 2048.0f) + EPSN);
                *(GASQ f32x4*)(out + o + colA) = acc[ai][0][m][0] * r * gA0; *(GASQ f32x4*)(out + o + colA + 4) = acc[ai][0][m][1] * r * gA1;
                *(GASQ f32x4*)(out + o + colB) = acc[ai][1][m][0] * r * gB0; *(GASQ f32x4*)(out + o + colB + 4) = acc[ai][1][m][1] * r * gB1; }
    }
};
struct EpiNone {
    static constexpr bool PERM = true, AFTER_DRAIN = false;
    float* dummy;
    __device__ __forceinline__ void init(f32x4 (&acc)[2][2][4][2], const Unit&, int, int, int, int) const { EPI_ZERO(acc); }
    __device__ __forceinline__ void operator()(const f32x4 (&acc)[2][2][4][2], const Unit& u, int wr, int wc, int fr, int fq) const {
        float s = 0.f;
        EPI_ROWS_BEGIN
            s += (sq4(a0) + sq4(a1)) + (sq4(b0) + sq4(b1));
        EPI_ROWS_END
        if (s == 12345.678f) dummy[0] = s;
    }
};
template <class Epi, class Sched, bool ALIGN_EPI = false, bool SP2 = false>
__device__ __forceinline__ void gemm_phase(PG8_LAS unsigned char* lds, const Gemm g, const Sched& S, const Epi& E) {
    const int tid = threadIdx.x, wid = __builtin_amdgcn_readfirstlane(tid >> 6), lane = tid & 63, wr = wid >> 2, wc = wid & 3, fr = lane & 15, fq = lane >> 4;
    unsigned RA[2], RB[2], C2[2];
#pragma unroll
    for (int i = 0; i < 2; ++i) { int R, C; stage_rc(tid * 16 + i * 8192, R, C); const int Rb = Epi::PERM ? ((R & ~31) + perm32(R & 31)) : R;
        RA[i] = (unsigned)R; RB[i] = (unsigned)Rb; C2[i] = (unsigned)C * 2u; }
    const size_t kstep = (size_t)(BK * 2);
    const unsigned ldsw = (unsigned)wid * 1024u;
    const int aoff = lds_byte(wr * 64 + fr, fq * 8), boff = lds_byte(wc * 32 + fr, fq * 8);
#define PG8_SA(b, h) (((b) * 2 + (h)) * HTB)
#define PG8_SB(b, h) ((4 + (b) * 2 + (h)) * HTB)
#define PG8_STAGE(bufoff, gbase, Rr, K2_) do { _Pragma("unroll") for (int _i = 0; _i < 2; ++_i) \
        __builtin_amdgcn_global_load_lds((const unsigned*)((const char*)(gbase) + ((Rr)[_i] * (unsigned)(K2_) + C2[_i])), (PG8_LAS unsigned*)(lds + (bufoff) + ldsw + _i * 8192), 16, 0, 0); } while (0)
#define PG8_LDA(dst, b, h) do { _Pragma("unroll") for (int m = 0; m < 4; ++m) _Pragma("unroll") for (int k = 0; k < 2; ++k) dst[m][k] = *(const PG8_LAS bf16x8*)(lds + PG8_SA(b, h) + aoff + m * 2048 + k * 1024); } while (0)
#define PG8_LDB(dst, b, h) do { _Pragma("unroll") for (int n = 0; n < 2; ++n) _Pragma("unroll") for (int k = 0; k < 2; ++k) dst[n][k] = *(const PG8_LAS bf16x8*)(lds + PG8_SB(b, h) + boff + n * 2048 + k * 1024); } while (0)
#define PG8_MMA(ai, bj, At, Bt) do { __builtin_amdgcn_s_setprio(1); _Pragma("unroll") for (int m = 0; m < 4; ++m) _Pragma("unroll") for (int n = 0; n < 2; ++n) _Pragma("unroll") for (int k = 0; k < 2; ++k) \
        acc[ai][bj][m][n] = __builtin_amdgcn_mfma_f32_16x16x32_bf16(Bt[n][k], At[m][k], acc[ai][bj][m][n], 0, 0, 0); __builtin_amdgcn_s_setprio(0); } while (0)
#define PG8_WAIT_V(n) asm volatile("s_waitcnt vmcnt(" #n ")" ::: "memory")
#define PG8_WAIT_L(n) asm volatile("s_waitcnt lgkmcnt(" #n ")" ::: "memory")
#define PG8_BAR __builtin_amdgcn_s_barrier()
#define PG8_SCHED __builtin_amdgcn_sched_barrier(0)
    Unit cur, nxt; int ui = 0;
    if (!S.next(0, cur)) return;
    f32x4 acc[2][2][4][2];
    E.init(acc, cur, wr, wc, fr, fq);
    bf16x8 At[4][2], B0[2][2], B1[2][2];
    int K2c = 2 * S.K(cur, g), ntc = K2c / (2 * BK); size_t hstepc = (size_t)HALF * K2c;
    const char* cA = S.pA(cur, g, 2 * hstepc); const char* cB = S.pB(cur, g, 2 * hstepc);
    S.a_ready(cur);
    if constexpr (SP2) {
        PG8_STAGE(PG8_SB(0, 0), cB, RB, K2c); PG8_STAGE(PG8_SB(0, 1), cB + hstepc, RB, K2c); PG8_STAGE(PG8_SA(0, 0), cA, RA, K2c); PG8_STAGE(PG8_SA(0, 1), cA + hstepc, RA, K2c);
        if (wr == 1) PG8_BAR;
        PG8_WAIT_V(2); PG8_BAR;
        PG8_STAGE(PG8_SB(1, 0), cB + kstep, RB, K2c); PG8_STAGE(PG8_SA(1, 0), cA + kstep, RA, K2c); PG8_STAGE(PG8_SB(1, 1), cB + hstepc + kstep, RB, K2c);
        PG8_WAIT_V(6); PG8_BAR;
    } else {
        PG8_STAGE(PG8_SB(0, 0), cB, RB, K2c); PG8_STAGE(PG8_SA(0, 0), cA, RA, K2c); PG8_STAGE(PG8_SB(0, 1), cB + hstepc, RB, K2c); PG8_STAGE(PG8_SA(0, 1), cA + hstepc, RA, K2c);
        if (wr == 1) PG8_BAR;
        PG8_WAIT_V(4); PG8_BAR;
        PG8_STAGE(PG8_SB(1, 0), cB + kstep, RB, K2c); PG8_STAGE(PG8_SA(1, 0), cA + kstep, RA, K2c); PG8_STAGE(PG8_SB(1, 1), cB + hstepc + kstep, RB, K2c);
        PG8_WAIT_V(6); PG8_BAR;
    }
    for (;;) {
        const bool has_next = S.next(ui + 1, nxt);
        const int K2n = has_next ? 2 * S.K(nxt, g) : K2c; const size_t hstepn = (size_t)HALF * K2n;
        const char* nA = has_next ? S.pA(nxt, g, 2 * hstepn) : cA; const char* nB = has_next ? S.pB(nxt, g, 2 * hstepn) : cB;
        for (int t = 0; t < ntc; t += 2) {
            const bool last = (t == ntc - 2);
            const int K2x = last ? K2n : K2c; const size_t hstepx = last ? hstepn : hstepc;
            const char* a1 = cA + (size_t)(t + 1) * kstep;
            const char* a2 = last ? nA : cA + (size_t)(t + 2) * kstep; const char* b2 = last ? nB : cB + (size_t)(t + 2) * kstep;
            const char* a3 = a2 + kstep; const char* b3 = b2 + kstep;
            if (last && has_next) S.a_ready(nxt);
            if constexpr (SP2) {
            PG8_LDB(B0, 0, 0); PG8_LDB(B1, 0, 1); PG8_SCHED; PG8_LDA(At, 0, 0); PG8_STAGE(PG8_SA(1, 1), a1 + hstepc, RA, K2c);
            PG8_WAIT_V(8); PG8_WAIT_L(0); PG8_BAR; PG8_MMA(0, 0, At, B0); PG8_MMA(0, 1, At, B1); PG8_BAR; PG8_SCHED;
            PG8_LDA(At, 0, 1); PG8_STAGE(PG8_SB(0, 0), b2, RB, K2x); PG8_STAGE(PG8_SB(0, 1), b2 + hstepx, RB, K2x); PG8_STAGE(PG8_SA(0, 0), a2, RA, K2x);
            PG8_WAIT_V(8); PG8_WAIT_L(0); PG8_BAR; PG8_MMA(1, 0, At, B0); PG8_MMA(1, 1, At, B1); PG8_BAR; PG8_SCHED;
            PG8_LDB(B0, 1, 0); PG8_LDB(B1, 1, 1); PG8_SCHED; PG8_LDA(At, 1, 0); PG8_STAGE(PG8_SA(0, 1), a2 + hstepx, RA, K2x);
            PG8_WAIT_V(8); PG8_WAIT_L(0); PG8_BAR; PG8_MMA(0, 0, At, B0); PG8_MMA(0, 1, At, B1); PG8_BAR; PG8_SCHED;
            PG8_LDA(At, 1, 1); PG8_STAGE(PG8_SB(1, 0), b3, RB, K2x); PG8_STAGE(PG8_SB(1, 1), b3 + hstepx, RB, K2x); PG8_STAGE(PG8_SA(1, 0), a3, RA, K2x);
            PG8_WAIT_V(8); PG8_WAIT_L(0); PG8_BAR; PG8_MMA(1, 0, At, B0); PG8_MMA(1, 1, At, B1); PG8_BAR; PG8_SCHED;
            } else {
            PG8_LDB(B0, 0, 0); PG8_SCHED; PG8_LDA(At, 0, 0); PG8_STAGE(PG8_SA(1, 1), a1 + hstepc, RA, K2c);
            PG8_WAIT_L(8); PG8_BAR; PG8_WAIT_L(0); PG8_MMA(0, 0, At, B0); PG8_BAR; PG8_SCHED;
            PG8_LDB(B1, 0, 1); PG8_STAGE(PG8_SB(0, 0), b2, RB, K2x);
            PG8_BAR; PG8_WAIT_L(0); PG8_MMA(0, 1, At, B1); PG8_BAR;
            PG8_LDA(At, 0, 1); PG8_STAGE(PG8_SA(0, 0), a2, RA, K2x);
            PG8_BAR; PG8_WAIT_L(0); PG8_MMA(1, 0, At, B0); PG8_BAR; PG8_SCHED;
            PG8_STAGE(PG8_SB(0, 1), b2 + hstepx, RB, K2x);
            PG8_WAIT_V(6); PG8_BAR; PG8_MMA(1, 1, At, B1); PG8_BAR;
            PG8_LDB(B0, 1, 0); PG8_SCHED; PG8_LDA(At, 1, 0); PG8_STAGE(PG8_SA(0, 1), a2 + hstepx, RA, K2x);
            PG8_WAIT_L(8); PG8_BAR; PG8_WAIT_L(0); PG8_MMA(0, 0, At, B0); PG8_BAR; PG8_SCHED;
            PG8_LDB(B1, 1, 1); PG8_STAGE(PG8_SB(1, 0), b3, RB, K2x);
            PG8_BAR; PG8_WAIT_L(0); PG8_MMA(0, 1, At, B1); PG8_BAR;
            PG8_LDA(At, 1, 1); PG8_STAGE(PG8_SA(1, 0), a3, RA, K2x);
            PG8_BAR; PG8_WAIT_L(0); PG8_MMA(1, 0, At, B0); PG8_BAR; PG8_SCHED;
            PG8_STAGE(PG8_SB(1, 1), b3 + hstepx, RB, K2x);
            PG8_WAIT_V(6); PG8_BAR; PG8_MMA(1, 1, At, B1); PG8_BAR;
            }
        }
        if constexpr (ALIGN_EPI) { if (wr == 0) PG8_BAR; }
        if constexpr (!Epi::AFTER_DRAIN) { E(acc, cur, wr, wc, fr, fq); S.done(cur); }
        if (!has_next) break;
        E.init(acc, nxt, wr, wc, fr, fq);
        cur = nxt; cA = nA; cB = nB; K2c = K2n; hstepc = hstepn; ntc = K2c / (2 * BK); ++ui;
        if constexpr (ALIGN_EPI) { if (wr == 1) PG8_BAR; }
    }
    PG8_WAIT_V(0);
    if constexpr (!ALIGN_EPI) { if (wr == 0) PG8_BAR; }
    PG8_BAR;
    if constexpr (Epi::AFTER_DRAIN) { E.fused(acc, cur, wr, wc, fr, fq, lds, wid, lane); S.done(cur); }
#undef PG8_SA
#undef PG8_SB
#undef PG8_STAGE
#undef PG8_LDA
#undef PG8_LDB
#undef PG8_MMA
#undef PG8_WAIT_V
#undef PG8_WAIT_L
#undef PG8_BAR
#undef PG8_SCHED
}
}
namespace att {
#define ALAS __attribute__((address_space(3)))
#define AGAS __attribute__((address_space(1)))
typedef unsigned short bf16_t;
typedef short bf16x8 __attribute__((ext_vector_type(8)));
typedef float f32x16 __attribute__((ext_vector_type(16)));
typedef unsigned u32x4 __attribute__((ext_vector_type(4)));
typedef unsigned u32x2 __attribute__((ext_vector_type(2)));
typedef float f32x2_t __attribute__((ext_vector_type(2))); typedef __bf16 bf16x2_t __attribute__((ext_vector_type(2)));
constexpr int SEQ = 16384;
constexpr int VROW = 144, KBYTES = 64 * 400, VBYTES = 128 * VROW;
constexpr int VBASE = 2 * KBYTES, ATT_LDS = 2 * KBYTES + 3 * VBYTES;
__device__ __forceinline__ unsigned cvtpk(float lo, float hi) { f32x2_t v = {lo, hi}; bf16x2_t b = __builtin_convertvector(v, bf16x2_t); return __builtin_bit_cast(unsigned, b); }
__device__ __forceinline__ int crow(int r, int hi) { return (r & 3) + 8 * (r >> 2) + 4 * hi; }


#define ASB() __builtin_amdgcn_sched_barrier(0)
#define DSR128(dst, addr, off) asm volatile("ds_read_b128 %0, %1 offset:%2" : "=v"(dst) : "v"(addr), "i"(off))
#define LGKM_WAIT2(n, x, y) do { if ((n) >= 4) asm volatile("s_waitcnt lgkmcnt(4)" : "+v"(x), "+v"(y)); else if ((n) == 2) asm volatile("s_waitcnt lgkmcnt(2)" : "+v"(x), "+v"(y)); else asm volatile("s_waitcnt lgkmcnt(0)" : "+v"(x), "+v"(y)); } while (0)
#define LGKM_WAIT1(n, x) do { if ((n) >= 3) asm volatile("s_waitcnt lgkmcnt(3)" : "+v"(x)); else if ((n) == 2) asm volatile("s_waitcnt lgkmcnt(2)" : "+v"(x)); else if ((n) == 1) asm volatile("s_waitcnt lgkmcnt(1)" : "+v"(x)); else asm volatile("s_waitcnt lgkmcnt(0)" : "+v"(x)); } while (0)
template <int DQK, bool NOLDS = false> __device__ __forceinline__ void qk_tile(const ALAS unsigned char* kb, const bf16x8 (&qr)[DQK / 16], f32x16& p0, f32x16& p1) {
    constexpr int KROW = DQK * 2 + 16, ND = DQK / 16;
    const unsigned kaddr = (unsigned)(size_t)kb;
    bf16x8 fa[3], fb[3];
    asm volatile("s_waitcnt lgkmcnt(0)" ::: "memory");
    DSR128(fa[0], kaddr, 0); DSR128(fb[0], kaddr, 32 * KROW);
    DSR128(fa[1], kaddr, 32); DSR128(fb[1], kaddr, 32 * KROW + 32);
    DSR128(fa[2], kaddr, 64); DSR128(fb[2], kaddr, 32 * KROW + 64);
    __builtin_amdgcn_s_setprio(1);
#pragma unroll
    for (int d0 = 0; d0 < ND; ++d0) {
        const int sl = d0 % 3, rem = ND - 1 - d0;
        if (NOLDS) { if (d0 == 0) LGKM_WAIT2(0, fa[sl], fb[sl]); } else LGKM_WAIT2(rem >= 2 ? 4 : 2 * rem, fa[sl], fb[sl]);
        p0 = __builtin_amdgcn_mfma_f32_32x32x16_bf16(fa[sl], qr[d0], p0, 0, 0, 0); p1 = __builtin_amdgcn_mfma_f32_32x32x16_bf16(fb[sl], qr[d0], p1, 0, 0, 0);
        if (!NOLDS && d0 + 3 < ND) { DSR128(fa[sl], kaddr, (d0 + 3) * 32); DSR128(fb[sl], kaddr, 32 * KROW + (d0 + 3) * 32); }
    }
    __builtin_amdgcn_s_setprio(0);
}
template <bool NOLDS = false> __device__ __forceinline__ void pv_tile(const ALAS unsigned char* vb, const bf16x8 (&pf)[4], f32x16 (&o)[4]) {
    const unsigned vaddr = (unsigned)(size_t)vb;
    bf16x8 vf[4];
    asm volatile("s_waitcnt lgkmcnt(0)" ::: "memory");
    DSR128(vf[0], vaddr, 0); DSR128(vf[1], vaddr, 32); DSR128(vf[2], vaddr, 64); DSR128(vf[3], vaddr, 96);
    __builtin_amdgcn_s_setprio(1);
#pragma unroll
    for (int j = 0; j < 16; ++j) {
        const int sl = j & 3, rem = 15 - j;
        if (NOLDS) { if (j == 0) LGKM_WAIT1(0, vf[sl]); } else LGKM_WAIT1(rem >= 3 ? 3 : rem, vf[sl]);
        o[j >> 2] = __builtin_amdgcn_mfma_f32_32x32x16_bf16(vf[sl], pf[sl], o[j >> 2], 0, 0, 0);
        if (!NOLDS && j + 4 < 16) DSR128(vf[sl], vaddr, ((j + 4) >> 2) * 32 * VROW + ((j + 4) & 3) * 32);
    }
    __builtin_amdgcn_s_setprio(0);
}

__device__ __forceinline__ void gate_unit(ALAS unsigned char* lds, const bf16_t* Qh, const bf16_t* kmean_h, int qb, unsigned* cnt_h, unsigned* list_h) {
    constexpr int KROW = 272;
    if (qb == 0) return;
    int tid = threadIdx.x; asm volatile("" : "+v"(tid));
    const int lane = tid & 63, r32 = lane & 31, hi = lane >> 5, wid = __builtin_amdgcn_readfirstlane(tid >> 6);
    const int q = qb * 256 + wid * 32 + r32;
    bf16x8 qr[8];
    { const bf16_t* qp = Qh + (size_t)q * 1024 + 8 * hi;
#pragma unroll
      for (int d0 = 0; d0 < 8; ++d0) qr[d0] = *(const AGAS bf16x8*)(qp + 16 * d0); }
#pragma unroll
    for (int j = 0; j < 2; ++j) { const int idx = tid + 512 * j, row = idx >> 4, ch = idx & 15;
        *(ALAS u32x4*)(lds + row * KROW + ch * 16) = *(const AGAS u32x4*)(kmean_h + row * 128 + ch * 8); }
    __syncthreads();
    f32x16 p0, p1;
#pragma unroll
    for (int r = 0; r < 16; ++r) { p0[r] = 0.f; p1[r] = 0.f; }
    qk_tile<128>(lds + r32 * KROW + hi * 16, qr, p0, p1);
    float v1 = -3e38f, v2 = -3e38f, v3 = -3e38f; int i1 = -1, i2 = -1, i3 = -1;
#define TOP_INS(xv_, xn_) do { const float xv = (xv_); const int xn = (xn_); const bool g1 = xv > v1, g2 = xv > v2, g3 = xv > v3; \
        v3 = g2 ? v2 : (g3 ? xv : v3); i3 = g2 ? i2 : (g3 ? xn : i3); v2 = g1 ? v1 : (g2 ? xv : v2); i2 = g1 ? i1 : (g2 ? xn : i2); v1 = g1 ? xv : v1; i1 = g1 ? xn : i1; } while (0)
#pragma unroll
    for (int r = 0; r < 16; ++r) { const int n = crow(r, hi); TOP_INS(n < qb ? p0[r] : -3e38f, n); }
#pragma unroll
    for (int r = 0; r < 16; ++r) { const int n = 32 + crow(r, hi); TOP_INS(n < qb ? p1[r] : -3e38f, n); }
    { const float w1 = __shfl_xor(v1, 32), w2 = __shfl_xor(v2, 32), w3 = __shfl_xor(v3, 32); const int j1 = __shfl_xor(i1, 32), j2 = __shfl_xor(i2, 32), j3 = __shfl_xor(i3, 32);
      TOP_INS(w1, j1); TOP_INS(w2, j2); TOP_INS(w3, j3); }
#undef TOP_INS
    if (hi == 0) {
        if (i1 >= 0) { const unsigned pos = atomicAdd(cnt_h + i1, 1u); list_h[(size_t)i1 * SEQ + pos] = ((unsigned)q << 2) | 0u; }
        if (i2 >= 0) { const unsigned pos = atomicAdd(cnt_h + i2, 1u); list_h[(size_t)i2 * SEQ + pos] = ((unsigned)q << 2) | 1u; }
        if (i3 >= 0) { const unsigned pos = atomicAdd(cnt_h + i3, 1u); list_h[(size_t)i3 * SEQ + pos] = ((unsigned)q << 2) | 2u; }
    }
    __syncthreads();
}

template <int DQK, int MODE, int PROBE = 0>
__device__ __forceinline__ void unit(ALAS unsigned char* lds, const bf16_t* Q, int ldq, const bf16_t* K, int ldk, const bf16_t* VT, bf16_t* O, int qb,
                                     const unsigned* lst, int nvalid, bf16_t* part, float* ml, int h) {
    constexpr int KROW = DQK * 2 + 16, ND = DQK / 16, KCH = DQK / 8, KPT = 64 * KCH / 512;
    int tid = threadIdx.x; asm volatile("" : "+v"(tid));
    const int lane = tid & 63, r32 = lane & 31, hi = lane >> 5, wid = __builtin_amdgcn_readfirstlane(tid >> 6);
    const int q0 = qb * 256, qrel = wid * 32 + r32;
    const int T0 = MODE == 0 ? 0 : 4 * qb, NT = MODE == 0 ? 4 * qb + 4 : 4;
    u32x4 kst[KPT], vst[2];
    const int srow = tid >> 3, sc = tid & 7;
    unsigned kgo = (unsigned)(srow * ldk + 8 * sc), klo = (unsigned)(srow * KROW + 16 * sc);
    unsigned vgo = (unsigned)(srow * SEQ + 8 * sc), vlo = (unsigned)(srow * VROW + 32 * (sc >> 1) + 8 * (sc & 1));
#define ATT_LOAD(t) do { asm volatile("" : "+v"(kgo), "+v"(vgo)); const bf16_t* kt_ = K + (size_t)(64 * (T0 + (t))) * ldk; const bf16_t* vt_ = VT + 64 * (T0 + (t)); \
        _Pragma("unroll") for (int j = 0; j < KPT; ++j) kst[j] = *(const AGAS u32x4*)(kt_ + kgo + 64 * j); \
        vst[0] = *(const AGAS u32x4*)(vt_ + vgo); vst[1] = *(const AGAS u32x4*)(vt_ + (size_t)64 * SEQ + vgo); } while (0)
#define ATT_STORE(kb, vb) do { asm volatile("" : "+v"(klo), "+v"(vlo)); ALAS unsigned char* kb_ = lds + (kb) * KBYTES; ALAS unsigned char* vb_ = lds + VBASE + (vb) * VBYTES; \
        _Pragma("unroll") for (int j = 0; j < KPT; ++j) *(ALAS u32x4*)(kb_ + klo + 128 * j) = kst[j]; \
        _Pragma("unroll") for (int j = 0; j < 2; ++j) { ALAS unsigned char* vp = vb_ + vlo + j * 64 * VROW; \
            *(ALAS u32x2*)(vp) = (u32x2){vst[j].x, vst[j].y}; *(ALAS u32x2*)(vp + 16) = (u32x2){vst[j].z, vst[j].w}; } } while (0)
    ATT_LOAD(0);
    int qrow = q0 + qrel; unsigned slot = 0u; bool rowok = true;
    if (MODE == 1) { rowok = qrel < nvalid; const unsigned e = rowok ? *(const AGAS unsigned*)(lst + qrel) : 0u; qrow = (int)(e >> 2); slot = e & 3u; }
    const bool wave_ok = MODE == 1 ? (wid * 32 < nvalid) : true;
    bf16x8 qr[ND];
    { const bf16_t* qp = Q + (size_t)qrow * ldq + 8 * hi;
#pragma unroll
      for (int d0 = 0; d0 < ND; ++d0) qr[d0] = *(const AGAS bf16x8*)(qp + 16 * d0); }
    f32x16 o[4];
#pragma unroll
    for (int i = 0; i < 4; ++i)
#pragma unroll
        for (int r = 0; r < 16; ++r) o[i][r] = 0.f;
    float mrun = 0.f; f32x2_t l2 = (f32x2_t){0.f, 0.f}; bool first = true;
    const float NINF = -__builtin_inff();

    ATT_STORE(0, 0);
    __syncthreads();
    const bool lag = wid >= 4; bool pend = false;
    int vcur = 0, vprev = 2;
    bf16x8 pf[4];
#pragma unroll
    for (int i = 0; i < 4; ++i) pf[i] = (bf16x8){0, 0, 0, 0, 0, 0, 0, 0};
    for (int t = 0; t < NT; ++t) {
        const int buf = t & 1;
        if (PROBE != 1 && PROBE != 4 && PROBE != 5 && PROBE != 6 && t + 1 < NT) ATT_LOAD(t + 1);
        if (pend) { pv_tile<PROBE == 6>(lds + VBASE + vprev * VBYTES + r32 * VROW + hi * 16, pf, o); pend = false; }
        const int jb = t - (NT - 4); const bool band = MODE == 1 ? false : jb >= 0;
        const bool active = PROBE == 2 ? false : (band ? (64 * jb <= 32 * wid + 31) : wave_ok);
        if (active) {
            f32x16 p0, p1;
#pragma unroll
            for (int r = 0; r < 16; ++r) { p0[r] = 0.f; p1[r] = 0.f; }
            qk_tile<DQK, PROBE == 6>(lds + buf * KBYTES + r32 * KROW + hi * 16, qr, p0, p1);
            if (band) { const int kvb = 64 * jb + 4 * hi;
#pragma unroll
                for (int r = 0; r < 16; ++r) { const int kv = kvb + (r & 3) + 8 * (r >> 2); if (kv > qrel) p0[r] = NINF; if (kv + 32 > qrel) p1[r] = NINF; } }
            if (PROBE != 4 && PROBE != 6) {
            float mxa = __builtin_fmaxf(__builtin_fmaxf(p0[0], p0[1]), p0[2]), mxb = __builtin_fmaxf(__builtin_fmaxf(p1[0], p1[1]), p1[2]);
            mxa = __builtin_fmaxf(__builtin_fmaxf(mxa, p0[3]), p1[3]);
#pragma unroll
            for (int r = 4; r < 16; r += 2) { mxa = __builtin_fmaxf(__builtin_fmaxf(mxa, p0[r]), p0[r + 1]); mxb = __builtin_fmaxf(__builtin_fmaxf(mxb, p1[r]), p1[r + 1]); }
            float mx = __builtin_fmaxf(mxa, mxb);
            { auto rr = __builtin_amdgcn_permlane32_swap(__float_as_uint(mx), __float_as_uint(mx), false, false); mx = __builtin_fmaxf(__uint_as_float(rr[0]), __uint_as_float(rr[1])); }
            const bool need = first ? (__builtin_fabsf(mx) > 16.0f) : (mx > mrun + 16.0f);
            if (__any(need)) { const float mnew = first ? mx : fmaxf(mrun, mx); const float al = __builtin_amdgcn_exp2f(mrun - mnew); l2 = l2 * al;
                if (!first) {
#pragma unroll
                for (int i = 0; i < 4; ++i)
#pragma unroll
                    for (int r = 0; r < 16; ++r) o[i][r] *= al; }
                mrun = mnew; }
            first = false;
            if (__all(mrun == 0.0f)) {
#pragma unroll
                for (int r = 0; r < 16; r += 2) { p0[r] = __builtin_amdgcn_exp2f(p0[r]); p0[r + 1] = __builtin_amdgcn_exp2f(p0[r + 1]); p1[r] = __builtin_amdgcn_exp2f(p1[r]); p1[r + 1] = __builtin_amdgcn_exp2f(p1[r + 1]);
                    l2 = l2 + ((f32x2_t){p0[r], p0[r + 1]} + (f32x2_t){p1[r], p1[r + 1]}); }
            } else {
#pragma unroll
                for (int r = 0; r < 16; r += 2) { p0[r] = __builtin_amdgcn_exp2f(p0[r] - mrun); p0[r + 1] = __builtin_amdgcn_exp2f(p0[r + 1] - mrun); p1[r] = __builtin_amdgcn_exp2f(p1[r] - mrun); p1[r + 1] = __builtin_amdgcn_exp2f(p1[r + 1] - mrun);
                    l2 = l2 + ((f32x2_t){p0[r], p0[r + 1]} + (f32x2_t){p1[r], p1[r + 1]}); }
            }
            }
            { u32x4 w;
              w = (u32x4){cvtpk(p0[0], p0[1]), cvtpk(p0[2], p0[3]), cvtpk(p0[4], p0[5]), cvtpk(p0[6], p0[7])}; pf[0] = __builtin_bit_cast(bf16x8, w);
              w = (u32x4){cvtpk(p0[8], p0[9]), cvtpk(p0[10], p0[11]), cvtpk(p0[12], p0[13]), cvtpk(p0[14], p0[15])}; pf[1] = __builtin_bit_cast(bf16x8, w);
              w = (u32x4){cvtpk(p1[0], p1[1]), cvtpk(p1[2], p1[3]), cvtpk(p1[4], p1[5]), cvtpk(p1[6], p1[7])}; pf[2] = __builtin_bit_cast(bf16x8, w);
              w = (u32x4){cvtpk(p1[8], p1[9]), cvtpk(p1[10], p1[11]), cvtpk(p1[12], p1[13]), cvtpk(p1[14], p1[15])}; pf[3] = __builtin_bit_cast(bf16x8, w); }
            if (PROBE == 5) { o[0][0] += __builtin_bit_cast(float, (int)pf[0][0] | ((int)pf[3][1] << 16)); } else if (lag) pend = true; else pv_tile<PROBE == 6>(lds + VBASE + vcur * VBYTES + r32 * VROW + hi * 16, pf, o);
        }
        const int vnext = vcur == 2 ? 0 : vcur + 1;
        if (PROBE != 1 && PROBE != 4 && PROBE != 5 && PROBE != 6 && t + 1 < NT) ATT_STORE(buf ^ 1, vnext);
        if (PROBE != 3) __syncthreads();
        vprev = vcur; vcur = vnext;
    }
    if (pend) pv_tile<PROBE == 6>(lds + VBASE + vprev * VBYTES + r32 * VROW + hi * 16, pf, o);
    __syncthreads();
#undef ATT_LOAD
#undef ATT_STORE
    const float lrun = l2.x + l2.y;
    const float lt = lrun + __shfl_xor(lrun, 32);
    if (MODE == 0) {
        const float inv = 1.0f / lt;
        bf16_t* op = O + (size_t)qrow * 2048 + 4 * hi;
#pragma unroll
        for (int i = 0; i < 4; ++i)
#pragma unroll
            for (int g = 0; g < 4; ++g) { const u32x2 w = (u32x2){cvtpk(o[i][4 * g] * inv, o[i][4 * g + 1] * inv), cvtpk(o[i][4 * g + 2] * inv, o[i][4 * g + 3] * inv)}; *(AGAS u32x2*)(op + 32 * i + 8 * g) = w; }
    } else if (MODE == 1) {
        if (rowok) {
            const float inv = 1.0f / lt;
            const size_t pr = ((size_t)slot * SEQ + qrow) * 8 + h;
            bf16_t* op = part + pr * 128 + 64 * hi;
#pragma unroll
            for (int i = 0; i < 4; ++i)
#pragma unroll
                for (int g2 = 0; g2 < 2; ++g2) { const int r0 = 8 * g2;
                    const u32x4 w = (u32x4){cvtpk(o[i][r0] * inv, o[i][r0 + 1] * inv), cvtpk(o[i][r0 + 2] * inv, o[i][r0 + 3] * inv), cvtpk(o[i][r0 + 4] * inv, o[i][r0 + 5] * inv), cvtpk(o[i][r0 + 6] * inv, o[i][r0 + 7] * inv)};
                    *(AGAS u32x4*)(op + 16 * i + 8 * g2) = w; }
            if (hi == 0) { *(AGAS float*)(ml + pr * 2) = mrun; *(AGAS float*)(ml + pr * 2 + 1) = lt; }
        }
    } else {
        const int ns = qb < 3 ? qb : 3;
        float ms0 = -1e30f, ms1 = -1e30f, ms2 = -1e30f, ls0 = 0.f, ls1 = 0.f, ls2 = 0.f;
        if (ns > 0) { const size_t pr = ((size_t)0 * SEQ + qrow) * 8 + h; ms0 = *(const AGAS float*)(ml + pr * 2); ls0 = *(const AGAS float*)(ml + pr * 2 + 1); }
        if (ns > 1) { const size_t pr = ((size_t)1 * SEQ + qrow) * 8 + h; ms1 = *(const AGAS float*)(ml + pr * 2); ls1 = *(const AGAS float*)(ml + pr * 2 + 1); }
        if (ns > 2) { const size_t pr = ((size_t)2 * SEQ + qrow) * 8 + h; ms2 = *(const AGAS float*)(ml + pr * 2); ls2 = *(const AGAS float*)(ml + pr * 2 + 1); }
        const float M = fmaxf(fmaxf(mrun, ms0), fmaxf(ms1, ms2));
        const float w0 = __builtin_amdgcn_exp2f(mrun - M), w1 = ls0 * __builtin_amdgcn_exp2f(ms0 - M), w2 = ls1 * __builtin_amdgcn_exp2f(ms1 - M), w3 = ls2 * __builtin_amdgcn_exp2f(ms2 - M);
        const float inv = 1.0f / (w0 * lt + w1 + w2 + w3);
#pragma unroll
        for (int i = 0; i < 4; ++i)
#pragma unroll
            for (int r = 0; r < 16; ++r) o[i][r] *= w0;
#define MERGE_SLOT(sidx, wgt) do { const bf16_t* pp = part + (((size_t)(sidx) * SEQ + qrow) * 8 + h) * 128 + 64 * hi; \
            _Pragma("unroll") for (int i = 0; i < 4; ++i) _Pragma("unroll") for (int g2 = 0; g2 < 2; ++g2) { const u32x4 w = *(const AGAS u32x4*)(pp + 16 * i + 8 * g2); const int r0 = 8 * g2; \
                o[i][r0] += (wgt) * __uint_as_float(w.x << 16); o[i][r0 + 1] += (wgt) * __uint_as_float(w.x & 0xffff0000u); o[i][r0 + 2] += (wgt) * __uint_as_float(w.y << 16); o[i][r0 + 3] += (wgt) * __uint_as_float(w.y & 0xffff0000u); \
                o[i][r0 + 4] += (wgt) * __uint_as_float(w.z << 16); o[i][r0 + 5] += (wgt) * __uint_as_float(w.z & 0xffff0000u); o[i][r0 + 6] += (wgt) * __uint_as_float(w.w << 16); o[i][r0 + 7] += (wgt) * __uint_as_float(w.w & 0xffff0000u); } } while (0)
        if (ns > 0) MERGE_SLOT(0, w1);
        if (ns > 1) MERGE_SLOT(1, w2);
        if (ns > 2) MERGE_SLOT(2, w3);
#undef MERGE_SLOT
        bf16_t* op = O + (size_t)qrow * 2048 + 4 * hi;
#pragma unroll
        for (int i = 0; i < 4; ++i)
#pragma unroll
            for (int g = 0; g < 4; ++g) { const u32x2 w = (u32x2){cvtpk(o[i][4 * g] * inv, o[i][4 * g + 1] * inv), cvtpk(o[i][4 * g + 2] * inv, o[i][4 * g + 3] * inv)}; *(AGAS u32x2*)(op + 32 * i + 8 * g) = w; }
    }
}
}
#include <hip/hip_cooperative_groups.h>
namespace cg = cooperative_groups;
#define LAS __attribute__((address_space(3)))
typedef unsigned short bf16;
typedef unsigned v4u __attribute__((ext_vector_type(4)));
typedef unsigned v2u __attribute__((ext_vector_type(2)));
typedef float f32x4 __attribute__((ext_vector_type(4)));
constexpr int S = 16384, DM = 2048, DFF = 5632, INC = 5184;
constexpr size_t MiB = 1u << 20;
constexpr size_t WS_SSQC = 0, WS_SSQ1 = 64 * 1024, WS_SSQ2 = 128 * 1024, WS_SSQ3 = 192 * 1024, WS_KMEAN = 256 * 1024, WS_CNT = 384 * 1024, WS_PCNT = 392 * 1024  ;
constexpr size_t WS_LIST = 192 * MiB  , WS_PART = 256 * MiB  , WS_ML = 352 * MiB  ;
constexpr size_t WS_WIN = 2 * MiB, WS_WVMB = 19 * MiB, WS_WK = 23 * MiB, WS_WV = 24 * MiB, WS_WO = 25 * MiB, WS_WGU = 33 * MiB, WS_WD = 77 * MiB, WS_WPG = 99 * MiB, WS_WPE = 107 * MiB;
constexpr size_t WS_PB = 108 * MiB, WS_T128 = 116 * MiB, WS_T64 = 124 * MiB, WS_A0 = 128 * MiB, WS_HB = 192 * MiB;
constexpr size_t WS_QMLA = 256 * MiB, WS_KMLA = 304 * MiB, WS_VTMLA = 352 * MiB, WS_CKV = 384 * MiB, WS_QMB = 400 * MiB, WS_KMB = 432 * MiB, WS_VTMB = 464 * MiB, WS_FF = 256 * MiB, WS_END = 496 * MiB;
constexpr int NWIN = 4352;
constexpr int LDS_BYTES = 133120, MISC_OFF = 131072;
constexpr size_t WS_BAR = 512 * 1024, WS_DUMMY = 448 * 1024;

__device__ const float INV128[64] = {1.000000000e+00f, 8.659643531e-01f, 7.498942614e-01f, 6.493816376e-01f, 5.623413324e-01f, 4.869675338e-01f, 4.216965139e-01f, 3.651741147e-01f, 3.162277639e-01f, 2.738419771e-01f, 2.371373773e-01f, 2.053525001e-01f, 1.778279394e-01f, 1.539926529e-01f, 1.333521307e-01f, 1.154782027e-01f, 1.000000015e-01f, 8.659642935e-02f, 7.498941571e-02f, 6.493816525e-02f, 5.623413250e-02f, 4.869675264e-02f, 4.216965288e-02f, 3.651741147e-02f, 3.162277490e-02f, 2.738419734e-02f, 2.371373773e-02f, 2.053525113e-02f, 1.778279431e-02f, 1.539926510e-02f, 1.333521493e-02f, 1.154782064e-02f, 9.999999776e-03f, 8.659643121e-03f, 7.498941850e-03f, 6.493816152e-03f, 5.623413250e-03f, 4.869675264e-03f, 4.216964822e-03f, 3.651741194e-03f, 3.162277630e-03f, 2.738419687e-03f, 2.371373586e-03f, 2.053524833e-03f, 1.778279431e-03f, 1.539926510e-03f, 1.333521446e-03f, 1.154781901e-03f, 1.000000047e-03f, 8.659643354e-04f, 7.498942432e-04f, 6.493816618e-04f, 5.623413017e-04f, 4.869675322e-04f, 4.216965172e-04f, 3.651741426e-04f, 3.162277571e-04f, 2.738419571e-04f, 2.371373703e-04f, 2.053525095e-04f, 1.778279402e-04f, 1.539926452e-04f, 1.333521504e-04f, 1.154782003e-04f};
__device__ const float INV64[32] = {1.000000000e+00f, 7.498942614e-01f, 5.623413324e-01f, 4.216965139e-01f, 3.162277639e-01f, 2.371373773e-01f, 1.778279394e-01f, 1.333521307e-01f, 1.000000015e-01f, 7.498941571e-02f, 5.623413250e-02f, 4.216965288e-02f, 3.162277490e-02f, 2.371373773e-02f, 1.778279431e-02f, 1.333521493e-02f, 9.999999776e-03f, 7.498941850e-03f, 5.623413250e-03f, 4.216964822e-03f, 3.162277630e-03f, 2.371373586e-03f, 1.778279431e-03f, 1.333521446e-03f, 1.000000047e-03f, 7.498942432e-04f, 5.623413017e-04f, 4.216965172e-04f, 3.162277571e-04f, 2.371373703e-04f, 1.778279402e-04f, 1.333521504e-04f};

__device__ __forceinline__ unsigned f2bf(float f) { unsigned u = __builtin_bit_cast(unsigned, f); return (u + 0x7fffu + ((u >> 16) & 1u)) >> 16; }
__device__ __forceinline__ unsigned pk2(float lo, float hi) { return f2bf(lo) | (f2bf(hi) << 16); }
__device__ __forceinline__ float wave_sum(float v) {
#pragma unroll
    for (int o = 1; o < 64; o <<= 1) v += __shfl_xor(v, o);
    return v;
}
__device__ __forceinline__ void sincos_acc(float ang, float& c, float& s) {
    double t = (double)ang * 0.15915494309189535; t -= rint(t); const double r = t * 6.283185307179586, r2 = r * r;
    double sp = 1.0, cp = 1.0;
#pragma unroll
    for (int k = 13; k >= 1; --k) { sp = 1.0 - sp * r2 * (1.0 / (double)((2 * k) * (2 * k + 1))); cp = 1.0 - cp * r2 * (1.0 / (double)((2 * k - 1) * (2 * k))); }
    s = (float)(r * sp); c = (float)cp;
}
__device__ __forceinline__ void transpose_item(const float* W, int ldw, int col0, int K, int k0, bf16* WT, int dstrow0, const float* gain, bool zero, LAS float* scr, int lane) {
    f32x4 v[8];
    const int kr = lane >> 3, n4 = 4 * (lane & 7);
#pragma unroll
    for (int i = 0; i < 8; ++i) v[i] = zero ? (f32x4){0.f, 0.f, 0.f, 0.f} : *(const f32x4*)(W + (size_t)(k0 + kr + 8 * i) * ldw + col0 + n4);
    if (gain) {
#pragma unroll
        for (int i = 0; i < 8; ++i) v[i] = v[i] * gain[k0 + kr + 8 * i]; }
#pragma unroll
    for (int i = 0; i < 8; ++i) { LAS float* d = scr + (kr + 8 * i) * 33 + n4; d[0] = v[i].x; d[1] = v[i].y; d[2] = v[i].z; d[3] = v[i].w; }
    asm volatile("s_waitcnt lgkmcnt(0)" ::: "memory");
    const int c = lane & 7;
#pragma unroll
    for (int j = 0; j < 4; ++j) { const int n = (lane >> 3) + 8 * j; const LAS float* s = scr + (8 * c) * 33 + n;
        v4u o; o.x = pk2(s[0 * 33], s[1 * 33]); o.y = pk2(s[2 * 33], s[3 * 33]); o.z = pk2(s[4 * 33], s[5 * 33]); o.w = pk2(s[6 * 33], s[7 * 33]);
        *(v4u*)(WT + (size_t)(dstrow0 + n) * K + k0 + 8 * c) = o; }
    asm volatile("s_waitcnt lgkmcnt(0)" ::: "memory");
}
__device__ __forceinline__ int win_src(int g) {
    const int t = g >> 3, cgp = g & 7;
    if (t < 4) return (2 * t + (cgp >> 2)) * 192 + (cgp & 3) * 32;
    if (t < 6) return (4 * (t - 4) + (cgp & 3)) * 192 + 128 + 32 * (cgp >> 2);
    if (t < 8) return 1536 + 256 * (t - 6) + 32 * cgp;
    if (t < 16) { const int base = t < 12 ? 2112 : 3136, uu = t < 12 ? t - 8 : t - 12, half = cgp >> 2, cc = (cgp & 3) * 32; return base + (2 * uu + (cc >> 6)) * 128 + 64 * half + (cc & 63); }
    return (cgp & 3) == 0 ? 2048 + 32 * (cgp >> 2) : -1;
}

typedef __attribute__((address_space(1))) unsigned gu32;
#define XB_TMO      128
#define XB_XCNT(j)  (256  + 64 * (j))
#define XB_XSUB(j)  (1280 + 64 * (j))
#define XB_XGEN(j)  (2304 + 64 * (j))
#define XB_TOP      3328
#define XB_TOPGEN   3392
#define XCD_BAR_WORDS 3456
#define XB_SPIN_CAP (1u << 18)

__device__ __forceinline__ unsigned xb_ld(unsigned* p)              { return __hip_atomic_load(p, __ATOMIC_RELAXED, __HIP_MEMORY_SCOPE_AGENT); }
__device__ __forceinline__ unsigned xb_add(unsigned* p, unsigned v) { return __hip_atomic_fetch_add(p, v, __ATOMIC_RELAXED, __HIP_MEMORY_SCOPE_AGENT); }
__device__ __forceinline__ unsigned xb_xcc_id() { return (unsigned)__builtin_amdgcn_s_getreg((3 << 11) | 20) & 0xFu; }
#define XB_SPIN(cond, bar) do { unsigned _sp = 0; while (cond) { __builtin_amdgcn_s_sleep(1); \
    if ((++_sp & 255u) == 0u) { if (xb_ld(&(bar)[XB_TMO])) break; if (_sp > XB_SPIN_CAP) { atomicAdd(&(bar)[XB_TMO], 1u); break; } } } } while (0)

struct XcdBarrier {
    unsigned* bar; unsigned x;
    volatile LAS unsigned* st;
};

__device__ __forceinline__ XcdBarrier xcd_barrier_post(unsigned* bar, volatile LAS unsigned* st) {
    XcdBarrier b; b.bar = bar; b.x = xb_xcc_id(); b.st = st;
    if (threadIdx.x == 0) (void)xb_add(&bar[XB_XCNT(b.x)], 1u);
    return b;
}
__device__ __forceinline__ void xcd_barrier_complete(unsigned* bar, unsigned x, unsigned& nloc, unsigned& nx) {
    const unsigned G = gridDim.x * gridDim.y * gridDim.z;
    unsigned sum, cnt, mine, sp = 0u;
    for (;;) {
        sum = 0u; cnt = 0u; mine = 0u;
#pragma unroll
        for (unsigned j = 0; j < 16; ++j) { const unsigned c = xb_ld(&bar[XB_XCNT(j)]); sum += c; cnt += (c > 0u) ? 1u : 0u; mine = (j == x) ? c : mine; }
        if (sum == G) break;
        __builtin_amdgcn_s_sleep(1);
        if ((++sp & 255u) == 0u) { if (xb_ld(&bar[XB_TMO])) break; if (sp > XB_SPIN_CAP) { atomicAdd(&bar[XB_TMO], 1u); break; } }
    }
    nloc = mine > 0u ? mine : 1u; nx = cnt > 0u ? cnt : 1u;
}

__device__ __forceinline__ void xcd_barrier(const XcdBarrier& b) {
    asm volatile("s_waitcnt vmcnt(0)" ::: "memory");
    __syncthreads();
    if (threadIdx.x == 0) {
        unsigned* bar = b.bar;
        __builtin_amdgcn_s_waitcnt(0);
        unsigned nloc = b.st[0], nx = b.st[1];
        if (nloc == 0u) { xcd_barrier_complete(bar, b.x, nloc, nx); b.st[0] = nloc; b.st[1] = nx; }
        const unsigned old = xb_add(&bar[XB_XSUB(b.x)], 1u);
        const unsigned gen = old / nloc;
        if (old + 1u == (gen + 1u) * nloc) {
            __builtin_amdgcn_fence(__ATOMIC_RELEASE, "agent");
            asm volatile("s_waitcnt vmcnt(0)" ::: "memory");
            const unsigned og = xb_add(&bar[XB_TOP], 1u);
            const unsigned tg = og / nx;
            if (og + 1u == (tg + 1u) * nx) xb_add(&bar[XB_TOPGEN], 1u);
            else XB_SPIN(xb_ld(&bar[XB_TOPGEN]) == tg, bar);
            __builtin_amdgcn_fence(__ATOMIC_ACQUIRE, "agent");
            xb_add(&bar[XB_XGEN(b.x)], 1u);
            asm volatile("s_waitcnt vmcnt(0)" ::: "memory");
        } else {
            XB_SPIN(xb_ld(&bar[XB_XGEN(b.x)]) == gen, bar);
            __builtin_amdgcn_fence(__ATOMIC_ACQUIRE, "agent");
            asm volatile("s_waitcnt vmcnt(0)" ::: "memory");
        }
    }
    __syncthreads();
}

struct Args { const float* in[16]; float* out; unsigned char* ws; int ph_lo, ph_hi; };
enum { I_X = 0, I_P, I_POS, I_ANORM, I_WIN, I_KVNORM, I_WUKV, I_WO, I_FNORM, I_WG, I_WU, I_WD, I_PNORM, I_WPG, I_WPE, I_FINAL };

template <class Epi> __device__ __forceinline__ void run_gemm(LAS unsigned char* lds, const bf16* A, const bf16* Bt, int M, int N, int K, const Epi& E) {
    asm volatile("" : "+s"(M), "+s"(N), "+s"(K));
    pg8::Gemm g{A, Bt, M, N, K}; pg8::StaticOrder So; So.init(M, N, (int)gridDim.x, (int)blockIdx.x);
    pg8::gemm_phase<Epi, pg8::StaticOrder, true, true>(lds, g, So, E);
}

template <class E0, class E1> __device__ __forceinline__ void run_gemm2(LAS unsigned char* lds, const bf16* A0_, const bf16* B0_, int M0, int N0, const bf16* A1_, const bf16* B1_, int M1, int N1, int K, const E0& e0, const E1& e1) {
    asm volatile("" : "+s"(M0), "+s"(N0), "+s"(M1), "+s"(N1), "+s"(K));
    pg8::Gemm g{A0_, B0_, M0, N0, K}; pg8::DualOrder So; So.init(M0, N0, M1, N1, (int)gridDim.x, (int)blockIdx.x, A1_, B1_);
    pg8::EpiDual<E0, E1> E{e0, e1};
    pg8::gemm_phase<pg8::EpiDual<E0, E1>, pg8::DualOrder, true, true>(lds, g, So, E);
}
template <class E0, class E1, class E2> __device__ __forceinline__ void run_gemm3(LAS unsigned char* lds, const bf16* A0_, const bf16* B0_, int M0, int N0, int K0, const bf16* A1_, const bf16* B1_, int M1, int N1, int K1,
                                                                               const bf16* A2_, const bf16* B2_, int M2, int N2, int K2, const E0& e0, const E1& e1, const E2& e2) {
    asm volatile("" : "+s"(M0), "+s"(N0), "+s"(K0), "+s"(M1), "+s"(N1), "+s"(K1), "+s"(M2), "+s"(N2), "+s"(K2));
    pg8::Gemm g{A0_, B0_, M0, N0, K0}; pg8::TriOrder So; So.init(M0, N0, M1, N1, M2, N2, (int)gridDim.x, (int)blockIdx.x, A1_, B1_, K1, A2_, B2_, K2);
    pg8::EpiTri<E0, E1, E2> E{e0, e1, e2};
    pg8::gemm_phase<pg8::EpiTri<E0, E1, E2>, pg8::TriOrder, true, true>(lds, g, So, E);
}
__global__ void __launch_bounds__(512) fwd(Args a) {
    extern __shared__ __attribute__((aligned(16))) unsigned char lds_raw[];
    LAS unsigned char* lds = (LAS unsigned char*)lds_raw;
    const int tid = threadIdx.x, lane = tid & 63, wave = __builtin_amdgcn_readfirstlane(tid >> 6);
    const int G = gridDim.x, bx = blockIdx.x;
    const int vcu = (G % 8 == 0) ? (bx % 8) * (G / 8) + bx / 8 : bx;
#define PTRS \
        unsigned char* ws = a.ws; asm volatile("" : "+s"(ws));     \
        float* ssqc = (float*)(ws + WS_SSQC); float* ssq1 = (float*)(ws + WS_SSQ1); float* ssq2 = (float*)(ws + WS_SSQ2); float* ssq3 = (float*)(ws + WS_SSQ3); bf16* kmean = (bf16*)(ws + WS_KMEAN); \
        bf16 *Win_t = (bf16*)(ws + WS_WIN), *Wvmb_t = (bf16*)(ws + WS_WVMB), *Wk_t = (bf16*)(ws + WS_WK), *Wv_t = (bf16*)(ws + WS_WV), *Wo_t = (bf16*)(ws + WS_WO), *Wgu_t = (bf16*)(ws + WS_WGU), *Wd_t = (bf16*)(ws + WS_WD), *Wpg_t = (bf16*)(ws + WS_WPG), *Wpe_t = (bf16*)(ws + WS_WPE); \
        bf16 *pb = (bf16*)(ws + WS_PB), *A0 = (bf16*)(ws + WS_A0), *hb = (bf16*)(ws + WS_HB), *qmla = (bf16*)(ws + WS_QMLA), *kmla = (bf16*)(ws + WS_KMLA), *vtmla = (bf16*)(ws + WS_VTMLA), *ckv = (bf16*)(ws + WS_CKV), \
             *qmb = (bf16*)(ws + WS_QMB), *kmb = (bf16*)(ws + WS_KMB), *vtmb = (bf16*)(ws + WS_VTMB), *ff = (bf16*)(ws + WS_FF); \
        float* tab128 = (float*)(ws + WS_T128); float* tab64 = (float*)(ws + WS_T64); unsigned* mcnt = (unsigned*)(ws + WS_CNT); unsigned* mlist = (unsigned*)(ws + WS_LIST); bf16* mpart = (bf16*)(ws + WS_PART); float* mml = (float*)(ws + WS_ML); \
        (void)mcnt; (void)mlist; (void)mpart; (void)mml; \
        (void)ssqc; (void)ssq1; (void)ssq2; (void)ssq3; (void)kmean; (void)Win_t; (void)Wvmb_t; (void)Wk_t; (void)Wv_t; (void)Wo_t; (void)Wgu_t; (void)Wd_t; (void)Wpg_t; (void)Wpe_t; (void)pb; (void)A0; (void)hb; (void)qmla; (void)kmla; (void)vtmla; (void)ckv; (void)qmb; (void)kmb; (void)vtmb; (void)ff; (void)tab128; (void)tab64;
    const int lo = a.ph_lo, hi = a.ph_hi;
    if (tid < 2) ((LAS unsigned*)(lds + MISC_OFF))[tid] = 0u;
    __syncthreads();
    XcdBarrier xbar = xcd_barrier_post((unsigned*)(a.ws + WS_BAR), (volatile LAS unsigned*)(lds + MISC_OFF));
#ifndef PH_MASK
#define PH_MASK 0x7ff
#endif
#define IN(k) (((PH_MASK >> (k)) & 1) && lo <= (k) && (k) < hi)
#define SEAM(k) do { if (IN(k) && IN((k) + 1)) { if (a.ph_lo < 0) cg::this_grid().sync();     \
        xcd_barrier(xbar); } } while (0)
    const int gw = vcu * 8 + wave, NGW = G * 8, gt = bx * 512 + tid, NGT = G * 512;

    if (IN(0)) { PTRS
#ifdef DUP_P0
      for (int dup_ = 0; dup_ < 2; ++dup_) {
#else
      {
#endif
        LAS float* scr = (LAS float*)(lds + wave * 16384);
        constexpr int C0 = (NWIN / 32) * 32, C1 = C0 + 32 * 32, C2 = C1 + 32 * 8, C3 = C2 + 32 * 8, C4 = C3 + 64 * 32, C5 = C4 + 352 * 32, C6 = C5 + 64 * 88, C7 = C6 + 64 * 32, C8 = C7 + 64 * 4;
        for (int it = gw; it < C8; it += NGW) {
            if (it < C0) { const int g = it % 136, kb = it / 136, src = win_src(g); transpose_item(a.in[I_WIN], INC, src < 0 ? 0 : src, 2048, 64 * kb, Win_t, 32 * g, nullptr, src < 0, scr, lane); }
            else if (it < C1) { const int r = it - C0, g = r % 32, kb = r / 32; transpose_item(a.in[I_WIN], INC, 4160 + 32 * g, 2048, 64 * kb, Wvmb_t, 32 * g, nullptr, false, scr, lane); }
            else if (it < C2) { const int r = it - C1, g = r % 32, kb = r / 32; transpose_item(a.in[I_WUKV], 2048, (g >> 2) * 256 + 32 * (g & 3), 512, 64 * kb, Wk_t, 32 * g, a.in[I_KVNORM], false, scr, lane); }
            else if (it < C3) { const int r = it - C2, g = r % 32, kb = r / 32; transpose_item(a.in[I_WUKV], 2048, (g >> 2) * 256 + 128 + 32 * (g & 3), 512, 64 * kb, Wv_t, 32 * g, a.in[I_KVNORM], false, scr, lane); }
            else if (it < C4) { const int r = it - C3, g = r % 64, kb = r / 64; transpose_item(a.in[I_WO], 2048, 32 * g, 2048, 64 * kb, Wo_t, 32 * g, nullptr, false, scr, lane); }
            else if (it < C5) { const int r = it - C4, g = r % 352, kb = r / 352, pn = g >> 3, bj = (g >> 2) & 1, cc = (g & 3) * 32; transpose_item(bj ? a.in[I_WU] : a.in[I_WG], DFF, 128 * pn + cc, 2048, 64 * kb, Wgu_t, 32 * g, a.in[I_FNORM], false, scr, lane); }
            else if (it < C6) { const int r = it - C5, g = r % 64, kb = r / 64; transpose_item(a.in[I_WD], 2048, 32 * g, DFF, 64 * kb, Wd_t, 32 * g, nullptr, false, scr, lane); }
            else if (it < C7) { const int r = it - C6, g = r % 64, kb = r / 64; transpose_item(a.in[I_WPG], 2048, 32 * g, 2048, 64 * kb, Wpg_t, 32 * g, a.in[I_PNORM], false, scr, lane); }
            else { const int r = it - C7, g = r % 64, kb = r / 64; transpose_item(a.in[I_WPE], 2048, 32 * g, 256, 64 * kb, Wpe_t, 32 * g, nullptr, false, scr, lane); }
        }
        { const float* gn = a.in[I_ANORM];
          for (int m = gw; m < S; m += NGW) { const f32x4* xr = (const f32x4*)(a.in[I_X] + (size_t)m * DM) + lane; f32x4 v[8]; float s = 0.f;
#pragma unroll
              for (int j = 0; j < 8; ++j) { v[j] = xr[64 * j]; s += (v[j].x * v[j].x + v[j].y * v[j].y) + (v[j].z * v[j].z + v[j].w * v[j].w); }
              const float rstd = 1.0f / sqrtf(wave_sum(s) * (1.0f / DM) + 1e-6f);
              v2u* o8 = (v2u*)(A0 + (size_t)m * DM) + lane;
#pragma unroll
              for (int j = 0; j < 8; ++j) { const f32x4 gg = ((const f32x4*)gn)[lane + 64 * j]; o8[64 * j] = (v2u){pk2(v[j].x * rstd * gg.x, v[j].y * rstd * gg.y), pk2(v[j].z * rstd * gg.z, v[j].w * rstd * gg.w)}; } } }
        for (int i = gt; i < S * 256 / 4; i += NGT) { const f32x4 v = ((const f32x4*)a.in[I_P])[i]; ((v2u*)pb)[i] = (v2u){pk2(v.x, v.y), pk2(v.z, v.w)}; }
        { const int* pos = (const int*)a.in[I_POS];
          for (int i = gt; i < S * 96; i += NGT) { const int row = i / 96, j = i % 96; const float pf = (float)pos[row]; float c, s;
              if (j < 64) { sincos_acc(pf * INV128[j], c, s); tab128[((size_t)row * 64 + j) * 2] = c; tab128[((size_t)row * 64 + j) * 2 + 1] = s; }
              else { sincos_acc(pf * INV64[j - 64], c, s); tab64[((size_t)row * 32 + (j - 64)) * 2] = c; tab64[((size_t)row * 32 + (j - 64)) * 2 + 1] = s; } } }
        for (int i = gt; i < 4 * S; i += NGT) ssqc[i] = 0.f;
        for (int i = gt; i < 512; i += NGT) mcnt[i] = 0u;
        for (int i = gt; i < 64 * 64; i += NGT) ((unsigned*)(ws + WS_PCNT))[i] = 0u;
      }
    }
    SEAM(0);
    if (IN(1)) { PTRS
        pg8::EpiProj E{qmla, kmla, ckv, qmb, kmb, ssqc, tab128, tab64};
        pg8::EpiT<false> Et{vtmb, S, nullptr, 0.f};
        pg8::EpiP Ep{(bf16*)a.out};
        run_gemm3(lds, A0, Win_t, S, NWIN, 2048, Wvmb_t, A0, 1024, S, 2048, pb, Wpe_t, S, 2048, 256, E, Et, Ep);
    }
    SEAM(1);
    if (IN(2)) { PTRS
        pg8::EpiKnope Ek{kmla, ssqc};
        pg8::EpiT<true> Et{vtmla, S, ssqc, 1.0f / 512.0f};
        run_gemm2(lds, ckv, Wk_t, S, 1024, Wv_t, ckv, 1024, S, 512, Ek, Et);
#ifdef DUP_P2
        run_gemm2(lds, ckv, Wk_t, S, 1024, Wv_t, ckv, 1024, S, 512, Ek, Et);
#endif
#ifdef DUP_KMEAN
      for (int dup_ = 0; dup_ < 2; ++dup_)
#endif
      {
        for (int i = gt; i < 64 * 1024; i += NGT) { const int n = i >> 10, col = i & 1023; const bf16* kp = kmb + (size_t)(256 * n) * 1024 + col; float s = 0.f;
            for (int r = 0; r < 256; ++r) s += pg8::bf2f(kp[(size_t)r * 1024]);
            kmean[((col >> 7) * 64 + n) * 128 + (col & 127)] = (bf16)f2bf(s * (1.0f / 256.0f)); }
      }
    }
    SEAM(2);
    if (IN(3)) { PTRS
        for (int v = vcu; v < 256; v += G) { const int h = v >> 5, s = v & 31;
#pragma unroll 1
            for (int i = 0; i < 2; ++i) { const int qb = i == 0 ? 63 - s : s;
                att::gate_unit(lds, qmb + h * 128, kmean + h * 64 * 128, qb, mcnt + h * 64, mlist + (size_t)h * 64 * S); }
#ifdef PROBE_MLA
#pragma unroll 1
            for (int i = 0; i < 2; ++i) { const int qb = i == 0 ? 63 - s : s;
                att::unit<192, 0, PROBE_MLA>(lds, qmla + h * 192, 1536, kmla + h * 192, 1536, vtmla + (size_t)h * 128 * S, A0 + h * 128, qb, nullptr, 0, nullptr, nullptr, h); }
#endif
#pragma unroll 1
            for (int i = 0; i < 2; ++i) { const int qb = i == 0 ? 63 - s : s;
                att::unit<192, 0>(lds, qmla + h * 192, 1536, kmla + h * 192, 1536, vtmla + (size_t)h * 128 * S, A0 + h * 128, qb, nullptr, 0, nullptr, nullptr, h); } }
    }
    SEAM(3);
    if (IN(4)) { PTRS
        LAS unsigned* pre = (LAS unsigned*)(lds + att::ATT_LDS);
        LAS unsigned* cntl = pre + 512;
        { const unsigned c = mcnt[tid]; cntl[tid] = c; unsigned vsum = (c + 255u) >> 8; pre[tid] = vsum; __syncthreads();
          for (int off = 1; off < 512; off <<= 1) { const unsigned add = tid >= off ? pre[tid - off] : 0u; __syncthreads(); vsum += add; pre[tid] = vsum; __syncthreads(); } }
        const int total = (int)pre[511];
#ifdef DUP_P4
      for (int dup_ = 0; dup_ < 2; ++dup_)
#endif
#pragma unroll 1
        for (int g = vcu; g < total; g += G) {
            int lo_ = 0, hi_ = 511;
            while (lo_ < hi_) { const int mid = (lo_ + hi_) >> 1; if ((int)pre[mid] > g) hi_ = mid; else lo_ = mid + 1; }
            const int li = __builtin_amdgcn_readfirstlane(lo_), c = g - (li ? (int)pre[li - 1] : 0), h = li >> 6, n = li & 63;
            const int cn = (int)cntl[li] - 256 * c, nvalid = cn < 256 ? cn : 256;
            att::unit<128, 1>(lds, qmb + h * 128, 1024, kmb + h * 128, 1024, vtmb + (size_t)h * 128 * S, nullptr, n, mlist + ((size_t)li * S + 256 * c), nvalid, mpart, mml, h);
        }
    }
    SEAM(4);
    if (IN(5)) { PTRS
        for (int v = vcu; v < 256; v += G) { const int h = v >> 5, s = v & 31;
#ifdef DUP_P5
#pragma unroll 1
            for (int i = 0; i < 4; ++i) { const int qb = (i & 1) == 0 ? 63 - s : s;
#else
#pragma unroll 1
            for (int i = 0; i < 2; ++i) { const int qb = i == 0 ? 63 - s : s;
#endif
                att::unit<128, 2>(lds, qmb + h * 128, 1024, kmb + h * 128, 1024, vtmb + (size_t)h * 128 * S, A0 + 1024 + h * 128, qb, nullptr, 0, mpart, mml, h); } }
    }
    SEAM(5);
#ifdef DUP_SYNC
    for (int dup_ = 0; dup_ < 10; ++dup_) xcd_barrier(xbar);
#endif
    if (IN(6)) { PTRS
#ifdef DUP_WO_NOEPI
        { pg8::EpiNone En{(float*)(ws + WS_DUMMY)}; run_gemm(lds, A0, Wo_t, S, 2048, 2048, En); }
#endif
#ifdef DUP_WO
        { pg8::EpiRes<true> Ed{a.in[I_X], hb, (float*)(ws + WS_DUMMY)}; run_gemm(lds, A0, Wo_t, S, 2048, 2048, Ed); }
#endif
        pg8::EpiRes<true> E{a.in[I_X], hb, ssq1}; run_gemm(lds, A0, Wo_t, S, 2048, 2048, E); }
    SEAM(6);
    if (IN(7)) { PTRS
#ifndef NO_SWI
        pg8::EpiSwiglu E{ff, ssq1}; run_gemm(lds, hb, Wgu_t, S, 2 * DFF, 2048, E);
#ifdef DUP_SWI
        run_gemm(lds, hb, Wgu_t, S, 2 * DFF, 2048, E);
#endif
#endif
    }
    SEAM(7);
    if (IN(8)) { PTRS pg8::EpiRes<false> E{hb, hb, ssq2}; run_gemm(lds, ff, Wd_t, S, 2048, DFF, E); }
    SEAM(8);
#ifndef FUSED_FINAL
#define FUSED_FINAL 1
#endif
    const bool fusedfin = FUSED_FINAL && (G == 256) && IN(9) && IN(10);
    if (IN(9)) { PTRS
        if (fusedfin) {
            int M_ = S, N_ = 2048, K_ = 2048; asm volatile("" : "+s"(M_), "+s"(N_), "+s"(K_));
            pg8::Gemm g{hb, Wpg_t, M_, N_, K_}; pg8::PanelOrder So{(int)blockIdx.x};
            pg8::EpiPleFused E{hb, (const bf16*)a.out, ssq2, ssq3, (unsigned*)(ws + WS_PCNT), a.out, a.in[I_FINAL]};
            pg8::gemm_phase<pg8::EpiPleFused, pg8::PanelOrder, true, true>(lds, g, So, E);
        } else { pg8::EpiPle E{hb, ff  , (const bf16*)a.out, ssq2, ssq3}; run_gemm(lds, hb, Wpg_t, S, 2048, 2048, E); }
    }
    if (!fusedfin) {
    SEAM(9);
    if (IN(10)) { PTRS const float* gn = a.in[I_FINAL];
        for (int m = gw; m < S; m += NGW) { const float r = 1.0f / sqrtf(ssq3[m] * (1.0f / DM) + 1e-6f); const v4u* xr = (const v4u*)(ff + (size_t)m * DM) + lane; f32x4* yr = (f32x4*)(a.out + (size_t)m * DM) + 2 * lane;
#pragma unroll
            for (int j = 0; j < 4; ++j) { const v4u w = xr[64 * j]; const f32x4 g0 = ((const f32x4*)gn)[2 * lane + 128 * j], g1 = ((const f32x4*)gn)[2 * lane + 128 * j + 1];
                f32x4 lo4 = (f32x4){__uint_as_float(w.x << 16), __uint_as_float(w.x & 0xffff0000u), __uint_as_float(w.y << 16), __uint_as_float(w.y & 0xffff0000u)};
                f32x4 hi4 = (f32x4){__uint_as_float(w.z << 16), __uint_as_float(w.z & 0xffff0000u), __uint_as_float(w.w << 16), __uint_as_float(w.w & 0xffff0000u)};
                yr[128 * j] = lo4 * r * g0; yr[128 * j + 1] = hi4 * r * g1; } } }
    }
#undef IN
#undef SEAM
}

#ifndef N_LAUNCH_MODE
#define N_LAUNCH_MODE 1
#endif
extern "C" void kernel_launch(void* const* d_in, const int* in_sizes, int n_in, void* d_out, int out_size, void* d_ws, size_t ws_size, hipStream_t stream) {
    static int grid = 0;
    if (grid == 0) {
        if (n_in != 16 || out_size != S * DM || ws_size < WS_END) { fprintf(stderr, "kernel_launch: unexpected shapes (n_in %d out %d ws %zu)\n", n_in, out_size, ws_size); grid = -1; return; }
        int dev = 0, cus = 0, per_cu = 0;
        hipGetDevice(&dev); hipDeviceGetAttribute(&cus, hipDeviceAttributeMultiprocessorCount, dev);
        if (hipFuncSetAttribute((const void*)fwd, hipFuncAttributeMaxDynamicSharedMemorySize, LDS_BYTES) != hipSuccess) { fprintf(stderr, "kernel_launch: hipFuncSetAttribute failed\n"); grid = -1; return; }
        if (hipOccupancyMaxActiveBlocksPerMultiprocessor(&per_cu, (const void*)fwd, 512, LDS_BYTES) != hipSuccess || per_cu < 1) { fprintf(stderr, "kernel_launch: occupancy query says %d\n", per_cu); per_cu = 1; }
        (void)hipGetLastError();
        grid = cus;
    }
    if (grid < 0) return;
    Args a{};
    for (int i = 0; i < 16; ++i) a.in[i] = (const float*)d_in[i];
    a.out = (float*)d_out; a.ws = (unsigned char*)d_ws;
    if (N_LAUNCH_MODE == 1) {
        (void)hipMemsetAsync((unsigned char*)d_ws + WS_BAR, 0, XCD_BAR_WORDS * 4, stream);
        a.ph_lo = 0; a.ph_hi = 11; void* args[] = {&a};
        hipError_t e = hipLaunchCooperativeKernel((const void*)fwd, dim3(grid), dim3(512), args, LDS_BYTES, stream);
        if (e != hipSuccess) fprintf(stderr, "cooperative launch failed: %s (grid %d)\n", hipGetErrorString(e), grid);
    } else {
        for (int p = 0; p < 11; ++p) { a.ph_lo = p; a.ph_hi = p + 1; hipLaunchKernelGGL(fwd, dim3(grid), dim3(512), LDS_BYTES, stream, a); }
    }
}
```

```cpp
#include <hip/hip_runtime.h>
#include <cstdio>
#include <cstdint>
namespace pg8 {
#define PG8_LAS __attribute__((address_space(3)))
typedef unsigned short bf16_t;
typedef short bf16x8 __attribute__((ext_vector_type(8)));
typedef float f32x4 __attribute__((ext_vector_type(4)));
typedef unsigned u32x4 __attribute__((ext_vector_type(4)));
constexpr int BM = 256, BK = 64, HALF = 128, HTB = HALF * BK * 2  , STAGE_BYTES = 8 * HTB, NXCD = 8, WGM = 8;

__host__ __device__ __forceinline__ int lds_byte(int r, int c) { const int st = (r >> 4) * 2 + (c >> 5), rr = r & 15, cc = c & 31, ob = rr * 64 + cc * 2; return st * 1024 + (ob ^ (((ob >> 9) & 1) << 5)); }
__host__ __device__ __forceinline__ void stage_rc(int b, int& R, int& C) { const int st = b / 1024, sb = b % 1024, swz = sb ^ (((sb >> 9) & 1) << 5); R = (st >> 1) * 16 + swz / 64; C = (st & 1) * 32 + (swz % 64) / 2; }
__host__ __device__ __forceinline__ int perm32(int rho) { const int n = rho >> 4, i = rho & 15; return 8 * (i >> 2) + 4 * n + (i & 3); }

struct Unit { int pm, pn, ty; };
struct Gemm { const bf16_t* A; const bf16_t* Bt; int M, N, K; };

struct StaticOrder {
    int nM, nN, nwg, G, c;
    __host__ __device__ void init(int M, int N, int G_, int c_) { nM = M / BM; nN = N / BM; nwg = nM * nN; G = G_; c = c_; }
    __host__ __device__ bool at(long L, Unit& u) const {
        if (L >= nwg) return false;
        int wgid = (int)L; { const int q = nwg / NXCD, r = nwg % NXCD, xcd = wgid % NXCD, off = wgid / NXCD; wgid = (xcd < r ? xcd * (q + 1) : r * (q + 1) + (xcd - r) * q) + off; }
        const int nig = WGM * nN, gid = wgid / nig, fm = gid * WGM, gsz = (nM - fm) < WGM ? (nM - fm) : WGM;
        u.pm = fm + ((wgid % nig) % gsz); u.pn = (wgid % nig) / gsz; u.ty = 0; return true;
    }
    __host__ __device__ bool next(int i, Unit& u) const { return at((long)i * G + c, u); }
    __device__ __forceinline__ const char* pA(const Unit& u, const Gemm& g, size_t tstep) const { return (const char*)g.A + (size_t)u.pm * tstep; }
    __device__ __forceinline__ const char* pB(const Unit& u, const Gemm& g, size_t tstep) const { return (const char*)g.Bt + (size_t)u.pn * tstep; }
    __device__ __forceinline__ int K(const Unit&, const Gemm& g) const { return g.K; }
    __device__ __forceinline__ void a_ready(const Unit&) const {}
    __device__ __forceinline__ void done(const Unit&) const {}
};
struct DualOrder {
    StaticOrder s0, s1; int G, c; const bf16_t* A1; const bf16_t* B1;
    __host__ __device__ void init(int M0, int N0, int M1, int N1, int G_, int c_, const bf16_t* A1_, const bf16_t* B1_) { s0.init(M0, N0, G_, c_); s1.init(M1, N1, G_, c_); G = G_; c = c_; A1 = A1_; B1 = B1_; }
    __host__ __device__ bool next(int i, Unit& u) const { const long L = (long)i * G + c; if (L < s0.nwg) return s0.at(L, u); const bool ok = s1.at(L - s0.nwg, u); u.ty = 1; return ok; }
    __device__ __forceinline__ const char* pA(const Unit& u, const Gemm& g, size_t tstep) const { return (const char*)(u.ty ? A1 : g.A) + (size_t)u.pm * tstep; }
    __device__ __forceinline__ const char* pB(const Unit& u, const Gemm& g, size_t tstep) const { return (const char*)(u.ty ? B1 : g.Bt) + (size_t)u.pn * tstep; }
    __device__ __forceinline__ int K(const Unit&, const Gemm& g) const { return g.K; }
    __device__ __forceinline__ void a_ready(const Unit&) const {}
    __device__ __forceinline__ void done(const Unit&) const {}
};
struct TriOrder {
    StaticOrder s0, s1, s2; int G, c; const bf16_t *A1, *B1, *A2, *B2; int K1, K2v;
    __host__ __device__ void init(int M0, int N0, int M1, int N1, int M2, int N2, int G_, int c_, const bf16_t* A1_, const bf16_t* B1_, int K1_, const bf16_t* A2_, const bf16_t* B2_, int K2_) {
        s0.init(M0, N0, G_, c_); s1.init(M1, N1, G_, c_); s2.init(M2, N2, G_, c_); G = G_; c = c_; A1 = A1_; B1 = B1_; K1 = K1_; A2 = A2_; B2 = B2_; K2v = K2_; }
    __host__ __device__ bool full(long L, Unit& u) const { if (L < s0.nwg) return s0.at(L, u); const bool ok = s1.at(L - s0.nwg, u); u.ty = 1; return ok; }
    __host__ __device__ bool next(int i, Unit& u) const {
        const int n01 = s0.nwg + s1.nwg, rf = n01 / G, rem = n01 % G;
        if (i < rf) return full((long)i * G + c, u);
        long j;
        if (rem == 0) j = (long)(i - rf) * G + c;
        else { if (c < rem) { if (i == rf) return full((long)i * G + c, u); return false; } j = (long)(i - rf) * (G - rem) + (c - rem); }
        const bool ok = s2.at(j, u); u.ty = 2; return ok;
    }
    __device__ __forceinline__ const char* pA(const Unit& u, const Gemm& g, size_t tstep) const { return (const char*)(u.ty == 0 ? g.A : (u.ty == 1 ? A1 : A2)) + (size_t)u.pm * tstep; }
    __device__ __forceinline__ const char* pB(const Unit& u, const Gemm& g, size_t tstep) const { return (const char*)(u.ty == 0 ? g.Bt : (u.ty == 1 ? B1 : B2)) + (size_t)u.pn * tstep; }
    __device__ __forceinline__ int K(const Unit& u, const Gemm& g) const { return u.ty == 0 ? g.K : (u.ty == 1 ? K1 : K2v); }
    __device__ __forceinline__ void a_ready(const Unit&) const {}
    __device__ __forceinline__ void done(const Unit&) const {}
};
template <class E0, class E1, class E2> struct EpiTri {
    static constexpr bool PERM = true, AFTER_DRAIN = false;
    E0 e0; E1 e1; E2 e2;
    __device__ __forceinline__ void init(f32x4 (&acc)[2][2][4][2], const Unit& u, int wr, int wc, int fr, int fq) const { if (u.ty == 0) e0.init(acc, u, wr, wc, fr, fq); else if (u.ty == 1) e1.init(acc, u, wr, wc, fr, fq); else e2.init(acc, u, wr, wc, fr, fq); }
    __device__ __forceinline__ void operator()(const f32x4 (&acc)[2][2][4][2], const Unit& u, int wr, int wc, int fr, int fq) const { if (u.ty == 0) e0(acc, u, wr, wc, fr, fq); else if (u.ty == 1) e1(acc, u, wr, wc, fr, fq); else e2(acc, u, wr, wc, fr, fq); }
};
template <class E0, class E1> struct EpiDual {
    static constexpr bool PERM = true, AFTER_DRAIN = false;
    E0 e0; E1 e1;
    __device__ __forceinline__ void init(f32x4 (&acc)[2][2][4][2], const Unit& u, int wr, int wc, int fr, int fq) const { if (u.ty == 0) e0.init(acc, u, wr, wc, fr, fq); else e1.init(acc, u, wr, wc, fr, fq); }
    __device__ __forceinline__ void operator()(const f32x4 (&acc)[2][2][4][2], const Unit& u, int wr, int wc, int fr, int fq) const { if (u.ty == 0) e0(acc, u, wr, wc, fr, fq); else e1(acc, u, wr, wc, fr, fq); }
};

__device__ __forceinline__ unsigned cvt_pk_bf16(float lo, float hi) { unsigned r; asm volatile("v_cvt_pk_bf16_f32 %0, %1, %2" : "=v"(r) : "v"(lo), "v"(hi)); return r; }
typedef float f32x2 __attribute__((ext_vector_type(2)));
typedef unsigned u32x2 __attribute__((ext_vector_type(2)));
#define GASQ __attribute__((address_space(1)))
constexpr float QS_MLA = 0.07216878364870322f * 1.4426950408889634f;
constexpr float QS_MB  = 0.08838834764831845f * 1.4426950408889634f;
constexpr float EPSN = 1e-6f;
__device__ __forceinline__ u32x4 pack8(f32x4 a, f32x4 b) { u32x4 w; w.x = cvt_pk_bf16(a[0], a[1]); w.y = cvt_pk_bf16(a[2], a[3]); w.z = cvt_pk_bf16(b[0], b[1]); w.w = cvt_pk_bf16(b[2], b[3]); return w; }
__device__ __forceinline__ float sq4(f32x4 a) { return (a[0] * a[0] + a[1] * a[1]) + (a[2] * a[2] + a[3] * a[3]); }
__device__ __forceinline__ float bf2f(unsigned short h) { return __uint_as_float(((unsigned)h) << 16); }
__device__ __forceinline__ void rope8(const float* tabp, f32x4 a0, f32x4 a1, f32x4 b0, f32x4 b1, f32x4& x0, f32x4& x1, f32x4& y0, f32x4& y1) {
    const f32x4 t0 = *(const f32x4*)tabp, t1 = *(const GASQ f32x4*)(tabp + 4), t2 = *(const GASQ f32x4*)(tabp + 8), t3 = *(const GASQ f32x4*)(tabp + 12);
    x0 = (f32x4){a0[0] * t0[0] - b0[0] * t0[1], a0[1] * t0[2] - b0[1] * t0[3], a0[2] * t1[0] - b0[2] * t1[1], a0[3] * t1[2] - b0[3] * t1[3]};
    x1 = (f32x4){a1[0] * t2[0] - b1[0] * t2[1], a1[1] * t2[2] - b1[1] * t2[3], a1[2] * t3[0] - b1[2] * t3[1], a1[3] * t3[2] - b1[3] * t3[3]};
    y0 = (f32x4){b0[0] * t0[0] + a0[0] * t0[1], b0[1] * t0[2] + a0[1] * t0[3], b0[2] * t1[0] + a0[2] * t1[1], b0[3] * t1[2] + a0[3] * t1[3]};
    y1 = (f32x4){b1[0] * t2[0] + a1[0] * t2[1], b1[1] * t2[2] + a1[1] * t2[3], b1[2] * t3[0] + a1[2] * t3[1], b1[3] * t3[2] + a1[3] * t3[3]};
}
#define EPI_ZERO(acc) _Pragma("unroll") for (int a_ = 0; a_ < 2; ++a_) _Pragma("unroll") for (int b_ = 0; b_ < 2; ++b_) _Pragma("unroll") for (int m_ = 0; m_ < 4; ++m_) _Pragma("unroll") for (int n_ = 0; n_ < 2; ++n_) acc[a_][b_][m_][n_] = (f32x4){0.f, 0.f, 0.f, 0.f}
#define EPI_ROWS_BEGIN _Pragma("unroll") for (int ai = 0; ai < 2; ++ai) _Pragma("unroll") for (int m = 0; m < 4; ++m) { const int row = u.pm * BM + ai * HALF + wr * 64 + m * 16 + fr; \
        const f32x4 a0 = acc[ai][0][m][0], a1 = acc[ai][0][m][1], b0 = acc[ai][1][m][0], b1 = acc[ai][1][m][1];
#define EPI_ROWS_END }
struct EpiProj {
    static constexpr bool PERM = true, AFTER_DRAIN = false;
    __device__ __forceinline__ void init(f32x4 (&acc)[2][2][4][2], const Unit&, int, int, int, int) const { EPI_ZERO(acc); }
    bf16_t *qmla, *kmla, *ckv, *qmb, *kmb; float* ssqc; const float* tab128; const float* tab64;
    __device__ __forceinline__ void operator()(const f32x4 (&acc)[2][2][4][2], const Unit& u, int wr, int wc, int fr, int fq) const {
        asm volatile("" : "+v"(fr), "+v"(fq));
        const int t = u.pn, c8 = wc * 32 + 8 * fq;
        EPI_ROWS_BEGIN
            if (t < 4) {
                *(GASQ u32x4*)(qmla + (size_t)row * 1536 + (2 * t) * 192 + c8) = pack8(a0 * QS_MLA, a1 * QS_MLA);
                *(GASQ u32x4*)(qmla + (size_t)row * 1536 + (2 * t + 1) * 192 + c8) = pack8(b0 * QS_MLA, b1 * QS_MLA);
            } else if (t < 6) {
                const int head = 4 * (t - 4) + (c8 >> 5), i0 = c8 & 31; f32x4 x0, x1, y0, y1;
                rope8(tab64 + ((size_t)row * 32 + i0) * 2, a0, a1, b0, b1, x0, x1, y0, y1);
                *(GASQ u32x4*)(qmla + (size_t)row * 1536 + head * 192 + 128 + i0) = pack8(x0 * QS_MLA, x1 * QS_MLA);
                *(GASQ u32x4*)(qmla + (size_t)row * 1536 + head * 192 + 160 + i0) = pack8(y0 * QS_MLA, y1 * QS_MLA);
            } else if (t < 8) {
                *(GASQ u32x4*)(ckv + (size_t)row * 512 + 256 * (t - 6) + c8) = pack8(a0, a1);
                *(GASQ u32x4*)(ckv + (size_t)row * 512 + 256 * (t - 6) + 128 + c8) = pack8(b0, b1);
                float s = (sq4(a0) + sq4(a1)) + (sq4(b0) + sq4(b1)); s += __shfl_xor(s, 16); s += __shfl_xor(s, 32);
                if (fq == 0) unsafeAtomicAdd(ssqc + row, s);
            } else if (t < 16) {
                const bool isq = t < 12; const int uu = isq ? t - 8 : t - 12; const int head = 2 * uu + (c8 >> 6), i0 = c8 & 63; f32x4 x0, x1, y0, y1;
                rope8(tab128 + ((size_t)row * 64 + i0) * 2, a0, a1, b0, b1, x0, x1, y0, y1);
                bf16_t* dst = (isq ? qmb : kmb) + (size_t)row * 1024 + head * 128 + i0; const float sc = isq ? QS_MB : 1.0f;
                *(GASQ u32x4*)(dst) = pack8(x0 * sc, x1 * sc);
                *(GASQ u32x4*)(dst + 64) = pack8(y0 * sc, y1 * sc);
            } else {
                if (c8 < 32) { f32x4 x0, x1, y0, y1;
                    rope8(tab64 + ((size_t)row * 32 + c8) * 2, a0, a1, b0, b1, x0, x1, y0, y1);
                    const u32x4 w1 = pack8(x0, x1), w2 = pack8(y0, y1);
#pragma unroll
                    for (int h = 0; h < 8; ++h) { *(GASQ u32x4*)(kmla + (size_t)row * 1536 + h * 192 + 128 + c8) = w1; *(GASQ u32x4*)(kmla + (size_t)row * 1536 + h * 192 + 160 + c8) = w2; } }
            }
        EPI_ROWS_END
    }
};
template <bool SCALE> struct EpiT {
    static constexpr bool PERM = true, AFTER_DRAIN = false;
    __device__ __forceinline__ void init(f32x4 (&acc)[2][2][4][2], const Unit&, int, int, int, int) const { EPI_ZERO(acc); }
    bf16_t* O; int ldc; const float* ssq; float invn;
    __device__ __forceinline__ void operator()(const f32x4 (&acc)[2][2][4][2], const Unit& u, int wr, int wc, int fr, int fq) const {
        asm volatile("" : "+v"(fr), "+v"(fq));
        const int c8 = wc * 32 + 8 * fq, colA = u.pn * BM + c8, colB = colA + HALF;
        f32x4 sa0 = (f32x4){1.f, 1.f, 1.f, 1.f}, sa1 = sa0, sb0 = sa0, sb1 = sa0;
        if (SCALE) { sa0 = *(const GASQ f32x4*)(ssq + colA); sa1 = *(const GASQ f32x4*)(ssq + colA + 4); sb0 = *(const GASQ f32x4*)(ssq + colB); sb1 = *(const GASQ f32x4*)(ssq + colB + 4);
#pragma unroll
            for (int j = 0; j < 4; ++j) { sa0[j] = __builtin_amdgcn_rsqf(sa0[j] * invn + EPSN); sa1[j] = __builtin_amdgcn_rsqf(sa1[j] * invn + EPSN); sb0[j] = __builtin_amdgcn_rsqf(sb0[j] * invn + EPSN); sb1[j] = __builtin_amdgcn_rsqf(sb1[j] * invn + EPSN); } }
        EPI_ROWS_BEGIN
            if (SCALE) { *(GASQ u32x4*)(O + (size_t)row * ldc + colA) = pack8(a0 * sa0, a1 * sa1); *(GASQ u32x4*)(O + (size_t)row * ldc + colB) = pack8(b0 * sb0, b1 * sb1); }
            else { *(GASQ u32x4*)(O + (size_t)row * ldc + colA) = pack8(a0, a1); *(GASQ u32x4*)(O + (size_t)row * ldc + colB) = pack8(b0, b1); }
        EPI_ROWS_END
    }
};
struct EpiKnope {
    static constexpr bool PERM = true, AFTER_DRAIN = false;
    __device__ __forceinline__ void init(f32x4 (&acc)[2][2][4][2], const Unit&, int, int, int, int) const { EPI_ZERO(acc); }
    bf16_t* kmla; const float* ssqc;
    __device__ __forceinline__ void operator()(const f32x4 (&acc)[2][2][4][2], const Unit& u, int wr, int wc, int fr, int fq) const {
        asm volatile("" : "+v"(fr), "+v"(fq));
        const int c8 = wc * 32 + 8 * fq;
        EPI_ROWS_BEGIN
            const float r = __builtin_amdgcn_rsqf(ssqc[row] * (1.0f / 512.0f) + EPSN);
            *(GASQ u32x4*)(kmla + (size_t)row * 1536 + (2 * u.pn) * 192 + c8) = pack8(a0 * r, a1 * r);
            *(GASQ u32x4*)(kmla + (size_t)row * 1536 + (2 * u.pn + 1) * 192 + c8) = pack8(b0 * r, b1 * r);
        EPI_ROWS_END
    }
};
__device__ __forceinline__ void unpack8(u32x4 w, f32x4& lo, f32x4& hi) {
    lo = (f32x4){__uint_as_float(w.x << 16), __uint_as_float(w.x & 0xffff0000u), __uint_as_float(w.y << 16), __uint_as_float(w.y & 0xffff0000u)};
    hi = (f32x4){__uint_as_float(w.z << 16), __uint_as_float(w.z & 0xffff0000u), __uint_as_float(w.w << 16), __uint_as_float(w.w & 0xffff0000u)}; }
template <bool BASEF32> struct EpiRes {
    static constexpr bool PERM = true, AFTER_DRAIN = false;
    const void* base; bf16_t* hb; float* ssq;
    __device__ __forceinline__ void init(f32x4 (&acc)[2][2][4][2], const Unit& u, int wr, int wc, int fr, int fq) const {
        asm volatile("" : "+v"(fr), "+v"(fq));
        const int colA = u.pn * BM + wc * 32 + 8 * fq, colB = colA + HALF;
#pragma unroll
        for (int ai = 0; ai < 2; ++ai)
#pragma unroll
            for (int m = 0; m < 4; ++m) { const size_t o = (size_t)(u.pm * BM + ai * HALF + wr * 64 + m * 16 + fr) * 2048;
                if (BASEF32) { const float* bp = (const float*)base; acc[ai][0][m][0] = *(const GASQ f32x4*)(bp + o + colA); acc[ai][0][m][1] = *(const GASQ f32x4*)(bp + o + colA + 4); acc[ai][1][m][0] = *(const GASQ f32x4*)(bp + o + colB); acc[ai][1][m][1] = *(const GASQ f32x4*)(bp + o + colB + 4); }
                else { const bf16_t* bp = (const bf16_t*)base; unpack8(*(const GASQ u32x4*)(bp + o + colA), acc[ai][0][m][0], acc[ai][0][m][1]); unpack8(*(const GASQ u32x4*)(bp + o + colB), acc[ai][1][m][0], acc[ai][1][m][1]); } }
    }
    __device__ __forceinline__ void operator()(const f32x4 (&acc)[2][2][4][2], const Unit& u, int wr, int wc, int fr, int fq) const {
        asm volatile("" : "+v"(fr), "+v"(fq));
        const int colA = u.pn * BM + wc * 32 + 8 * fq, colB = colA + HALF;
        EPI_ROWS_BEGIN
            const size_t o = (size_t)row * 2048;
            *(GASQ u32x4*)(hb + o + colA) = pack8(a0, a1); *(GASQ u32x4*)(hb + o + colB) = pack8(b0, b1);
            float s = (sq4(a0) + sq4(a1)) + (sq4(b0) + sq4(b1)); s += __shfl_xor(s, 16); s += __shfl_xor(s, 32);
            if (fq == 0) unsafeAtomicAdd(ssq + row, s);
        EPI_ROWS_END
    }
};
struct EpiSwiglu {
    static constexpr bool PERM = true, AFTER_DRAIN = false;
    __device__ __forceinline__ void init(f32x4 (&acc)[2][2][4][2], const Unit&, int, int, int, int) const { EPI_ZERO(acc); }
    bf16_t* ff; const float* ssq;
    __device__ __forceinline__ void operator()(const f32x4 (&acc)[2][2][4][2], const Unit& u, int wr, int wc, int fr, int fq) const {
        asm volatile("" : "+v"(fr), "+v"(fq));
        const int c8 = wc * 32 + 8 * fq;
        EPI_ROWS_BEGIN
            const float r = __builtin_amdgcn_rsqf(ssq[row] * (1.0f / 2048.0f) + EPSN);
            f32x4 g0 = a0 * r, g1 = a1 * r; const f32x4 u0 = b0 * r, u1 = b1 * r;
#pragma unroll
            for (int j = 0; j < 4; ++j) { g0[j] = g0[j] * __builtin_amdgcn_rcpf(1.0f + __builtin_amdgcn_exp2f(-1.4426950408889634f * g0[j])) * u0[j]; g1[j] = g1[j] * __builtin_amdgcn_rcpf(1.0f + __builtin_amdgcn_exp2f(-1.4426950408889634f * g1[j])) * u1[j]; }
            *(GASQ u32x4*)(ff + (size_t)row * 5632 + u.pn * 128 + c8) = pack8(g0, g1);
        EPI_ROWS_END
    }
};
__device__ __forceinline__ size_t p_off(int row) { return (size_t)(row >> 8) * 1048576 + (size_t)(row & 255) * 2048; }
struct EpiP {
    static constexpr bool PERM = true, AFTER_DRAIN = false;
    bf16_t* P;
    __device__ __forceinline__ void init(f32x4 (&acc)[2][2][4][2], const Unit&, int, int, int, int) const { EPI_ZERO(acc); }
    __device__ __forceinline__ void operator()(const f32x4 (&acc)[2][2][4][2], const Unit& u, int wr, int wc, int fr, int fq) const {
        asm volatile("" : "+v"(fr), "+v"(fq));
        const int colA = u.pn * BM + wc * 32 + 8 * fq, colB = colA + HALF;
        EPI_ROWS_BEGIN
            const size_t o = p_off(row);
            *(GASQ u32x4*)(P + o + colA) = pack8(a0, a1); *(GASQ u32x4*)(P + o + colB) = pack8(b0, b1);
        EPI_ROWS_END
    }
};
struct EpiPle {
    static constexpr bool PERM = true, AFTER_DRAIN = false;
    __device__ __forceinline__ void init(f32x4 (&acc)[2][2][4][2], const Unit&, int, int, int, int) const { EPI_ZERO(acc); }
    const bf16_t* hb; bf16_t* h3b; const bf16_t* P; const float* ssq2; float* ssq3;
    __device__ __forceinline__ void operator()(const f32x4 (&acc)[2][2][4][2], const Unit& u, int wr, int wc, int fr, int fq) const {
        asm volatile("" : "+v"(fr), "+v"(fq));
        const int colA = u.pn * BM + wc * 32 + 8 * fq, colB = colA + HALF;
        EPI_ROWS_BEGIN
            const size_t o = (size_t)row * 2048; const float r = __builtin_amdgcn_rsqf(ssq2[row] * (1.0f / 2048.0f) + EPSN);
            f32x4 h0, h1, h2, h3, p0, p1, p2, p3;
            unpack8(*(const GASQ u32x4*)(hb + o + colA), h0, h1); unpack8(*(const GASQ u32x4*)(hb + o + colB), h2, h3);
            { const size_t op = p_off(row); unpack8(*(const GASQ u32x4*)(P + op + colA), p0, p1); unpack8(*(const GASQ u32x4*)(P + op + colB), p2, p3); }
#define SIG(x) __builtin_amdgcn_rcpf(1.0f + __builtin_amdgcn_exp2f(-1.4426950408889634f * r * (x)))
#pragma unroll
            for (int j = 0; j < 4; ++j) { h0[j] += SIG(a0[j]) * p0[j]; h1[j] += SIG(a1[j]) * p1[j]; h2[j] += SIG(b0[j]) * p2[j]; h3[j] += SIG(b1[j]) * p3[j]; }
#undef SIG
            *(GASQ u32x4*)(h3b + o + colA) = pack8(h0, h1); *(GASQ u32x4*)(h3b + o + colB) = pack8(h2, h3);
            float s = (sq4(h0) + sq4(h1)) + (sq4(h2) + sq4(h3)); s += __shfl_xor(s, 16); s += __shfl_xor(s, 32);
            if (fq == 0) unsafeAtomicAdd(ssq3 + row, s);
        EPI_ROWS_END
    }
};

struct PanelOrder {
    int c;
    __device__ __forceinline__ bool next(int i, Unit& u) const { if (i >= 2) return false; const int v = (c & 7) * 32 + (c >> 3); u.pm = 32 * i + (v >> 3); u.pn = v & 7; u.ty = 0; return true; }
    __device__ __forceinline__ const char* pA(const Unit& u, const Gemm& g, size_t tstep) const { return (const char*)g.A + (size_t)u.pm * tstep; }
    __device__ __forceinline__ const char* pB(const Unit& u, const Gemm& g, size_t tstep) const { return (const char*)g.Bt + (size_t)u.pn * tstep; }
    __device__ __forceinline__ int K(const Unit&, const Gemm& g) const { return g.K; }
    __device__ __forceinline__ void a_ready(const Unit&) const {}
    __device__ __forceinline__ void done(const Unit&) const {}
};
struct EpiPleFused {
    static constexpr bool PERM = true, AFTER_DRAIN = false;
    const bf16_t* hb; const bf16_t* P; const float* ssq2; float* ssq3; unsigned* pcnt; float* out; const float* gfin;
    __device__ __forceinline__ void init(f32x4 (&acc)[2][2][4][2], const Unit&, int, int, int, int) const { EPI_ZERO(acc); }
    __device__ __forceinline__ void operator()(f32x4 (&acc)[2][2][4][2], const Unit& u, int wr, int wc, int fr, int fq) const {
        asm volatile("" : "+v"(fr), "+v"(fq));
        const int colA = u.pn * BM + wc * 32 + 8 * fq, colB = colA + HALF;
#pragma unroll
        for (int ai = 0; ai < 2; ++ai)
#pragma unroll
            for (int m = 0; m < 4; ++m) { const int row = u.pm * BM + ai * HALF + wr * 64 + m * 16 + fr;
                const size_t o = (size_t)row * 2048, op = p_off(row); const float r = __builtin_amdgcn_rsqf(ssq2[row] * (1.0f / 2048.0f) + EPSN);
                f32x4 h0, h1, h2, h3, p0, p1, p2, p3;
                unpack8(*(const GASQ u32x4*)(hb + o + colA), h0, h1); unpack8(*(const GASQ u32x4*)(hb + o + colB), h2, h3);
                unpack8(*(const GASQ u32x4*)(P + op + colA), p0, p1); unpack8(*(const GASQ u32x4*)(P + op + colB), p2, p3);
#define SIG(x) __builtin_amdgcn_rcpf(1.0f + __builtin_amdgcn_exp2f(-1.4426950408889634f * r * (x)))
#pragma unroll
                for (int j = 0; j < 4; ++j) { h0[j] += SIG(acc[ai][0][m][0][j]) * p0[j]; h1[j] += SIG(acc[ai][0][m][1][j]) * p1[j]; h2[j] += SIG(acc[ai][1][m][0][j]) * p2[j]; h3[j] += SIG(acc[ai][1][m][1][j]) * p3[j]; }
#undef SIG
                acc[ai][0][m][0] = h0; acc[ai][0][m][1] = h1; acc[ai][1][m][0] = h2; acc[ai][1][m][1] = h3;
                float s = (sq4(h0) + sq4(h1)) + (sq4(h2) + sq4(h3)); s += __shfl_xor(s, 16); s += __shfl_xor(s, 32);
                if (fq == 0) unsafeAtomicAdd(ssq3 + row, s); }
        asm volatile("s_waitcnt vmcnt(0)" ::: "memory");
        unsigned* pc = pcnt + 64 * u.pm;
        if (fr == 0 && fq == 0) __hip_atomic_fetch_add(pc, 1u, __ATOMIC_RELAXED, __HIP_MEMORY_SCOPE_AGENT);
        { unsigned sp = 0; while ((unsigned)__builtin_amdgcn_readfirstlane((int)__hip_atomic_load(pc, __ATOMIC_RELAXED, __HIP_MEMORY_SCOPE_AGENT)) < 64u) { __builtin_amdgcn_s_sleep(2); if (++sp > (1u << 22)) break; } }
        asm volatile("" ::: "memory");
        const f32x4 gA0 = *(const GASQ f32x4*)(gfin + colA), gA1 = *(const GASQ f32x4*)(gfin + colA + 4), gB0 = *(const GASQ f32x4*)(gfin + colB), gB1 = *(const GASQ f32x4*)(gfin + colB + 4);
#pragma unroll
        for (int ai = 0; ai < 2; ++ai)
#pragma unroll
            for (int m = 0; m < 4; ++m) { const int row = u.pm * BM + ai * HALF + wr * 64 + m * 16 + fr; const size_t o = (size_t)row * 2048;
                const float s = __uint_as_float(__hip_atomic_load((unsigned*)(ssq3 + row), __ATOMIC_RELAXED, __HIP_MEMORY_SCOPE_AGENT));
                const float r = __builtin_amdgcn_rsqf(s * (1.0f / 2048.0f) + EPSN);
                *(GASQ f32x4*)(out + o + colA) = acc[ai][0][m][0] * r * gA0; *(GASQ f32x4*)(out + o + colA + 4) = acc[ai][0][m][1] * r * gA1;
                *(GASQ f32x4*)(out + o + colB) = acc[ai][1][m][0] * r * gB0; *(GASQ f32x4*)(out + o + colB + 4) = acc[ai][1][m][1] * r * gB1; }
    }
};
struct EpiNone {
    static constexpr bool PERM = true, AFTER_DRAIN = false;
    float* dummy;
    __device__ __forceinline__ void init(f32x4 (&acc)[2][2][4][2], const Unit&, int, int, int, int) const { EPI_ZERO(acc); }
    __device__ __forceinline__ void operator()(const f32x4 (&acc)[2][2][4][2], const Unit& u, int wr, int wc, int fr, int fq) const {
        float s = 0.f;
        EPI_ROWS_BEGIN
            s += (sq4(a0) + sq4(a1)) + (sq4(b0) + sq4(b1));
        EPI_ROWS_END
        if (s == 12345.678f) dummy[0] = s;
    }
};
template <class Epi, class Sched, bool ALIGN_EPI = false, bool SP2 = false>
__device__ __forceinline__ void gemm_phase(PG8_LAS unsigned char* lds, const Gemm g, const Sched& S, const Epi& E) {
    const int tid = threadIdx.x, wid = __builtin_amdgcn_readfirstlane(tid >> 6), lane = tid & 63, wr = wid >> 2, wc = wid & 3, fr = lane & 15, fq = lane >> 4;
    unsigned RA[2], RB[2], C2[2];
#pragma unroll
    for (int i = 0; i < 2; ++i) { int R, C; stage_rc(tid * 16 + i * 8192, R, C); const int Rb = Epi::PERM ? ((R & ~31) + perm32(R & 31)) : R;
        RA[i] = (unsigned)R; RB[i] = (unsigned)Rb; C2[i] = (unsigned)C * 2u; }
    const size_t kstep = (size_t)(BK * 2);
    const unsigned ldsw = (unsigned)wid * 1024u;
    const int aoff = lds_byte(wr * 64 + fr, fq * 8), boff = lds_byte(wc * 32 + fr, fq * 8);
#define PG8_SA(b, h) (((b) * 2 + (h)) * HTB)
#define PG8_SB(b, h) ((4 + (b) * 2 + (h)) * HTB)
#define PG8_STAGE(bufoff, gbase, Rr, K2_) do { _Pragma("unroll") for (int _i = 0; _i < 2; ++_i) \
        __builtin_amdgcn_global_load_lds((const unsigned*)((const char*)(gbase) + ((Rr)[_i] * (unsigned)(K2_) + C2[_i])), (PG8_LAS unsigned*)(lds + (bufoff) + ldsw + _i * 8192), 16, 0, 0); } while (0)
#define PG8_LDA(dst, b, h) do { _Pragma("unroll") for (int m = 0; m < 4; ++m) _Pragma("unroll") for (int k = 0; k < 2; ++k) dst[m][k] = *(const PG8_LAS bf16x8*)(lds + PG8_SA(b, h) + aoff + m * 2048 + k * 1024); } while (0)
#define PG8_LDB(dst, b, h) do { _Pragma("unroll") for (int n = 0; n < 2; ++n) _Pragma("unroll") for (int k = 0; k < 2; ++k) dst[n][k] = *(const PG8_LAS bf16x8*)(lds + PG8_SB(b, h) + boff + n * 2048 + k * 1024); } while (0)
#define PG8_MMA(ai, bj, At, Bt) do { __builtin_amdgcn_s_setprio(1); _Pragma("unroll") for (int m = 0; m < 4; ++m) _Pragma("unroll") for (int n = 0; n < 2; ++n) _Pragma("unroll") for (int k = 0; k < 2; ++k) \
        acc[ai][bj][m][n] = __builtin_amdgcn_mfma_f32_16x16x32_bf16(Bt[n][k], At[m][k], acc[ai][bj][m][n], 0, 0, 0); __builtin_amdgcn_s_setprio(0); } while (0)
#define PG8_WAIT_V(n) asm volatile("s_waitcnt vmcnt(" #n ")" ::: "memory")
#define PG8_WAIT_L(n) asm volatile("s_waitcnt lgkmcnt(" #n ")" ::: "memory")
#define PG8_BAR __builtin_amdgcn_s_barrier()
#define PG8_SCHED __builtin_amdgcn_sched_barrier(0)
    Unit cur, nxt; int ui = 0;
    if (!S.next(0, cur)) return;
    f32x4 acc[2][2][4][2];
    E.init(acc, cur, wr, wc, fr, fq);
    bf16x8 At[4][2], B0[2][2], B1[2][2];
    int K2c = 2 * S.K(cur, g), ntc = K2c / (2 * BK); size_t hstepc = (size_t)HALF * K2c;
    const char* cA = S.pA(cur, g, 2 * hstepc); const char* cB = S.pB(cur, g, 2 * hstepc);
    S.a_ready(cur);
    if constexpr (SP2) {
        PG8_STAGE(PG8_SB(0, 0), cB, RB, K2c); PG8_STAGE(PG8_SB(0, 1), cB + hstepc, RB, K2c); PG8_STAGE(PG8_SA(0, 0), cA, RA, K2c); PG8_STAGE(PG8_SA(0, 1), cA + hstepc, RA, K2c);
        if (wr == 1) PG8_BAR;
        PG8_WAIT_V(2); PG8_BAR;
        PG8_STAGE(PG8_SB(1, 0), cB + kstep, RB, K2c); PG8_STAGE(PG8_SA(1, 0), cA + kstep, RA, K2c); PG8_STAGE(PG8_SB(1, 1), cB + hstepc + kstep, RB, K2c);
        PG8_WAIT_V(6); PG8_BAR;
    } else {
        PG8_STAGE(PG8_SB(0, 0), cB, RB, K2c); PG8_STAGE(PG8_SA(0, 0), cA, RA, K2c); PG8_STAGE(PG8_SB(0, 1), cB + hstepc, RB, K2c); PG8_STAGE(PG8_SA(0, 1), cA + hstepc, RA, K2c);
        if (wr == 1) PG8_BAR;
        PG8_WAIT_V(4); PG8_BAR;
        PG8_STAGE(PG8_SB(1, 0), cB + kstep, RB, K2c); PG8_STAGE(PG8_SA(1, 0), cA + kstep, RA, K2c); PG8_STAGE(PG8_SB(1, 1), cB + hstepc + kstep, RB, K2c);
        PG8_WAIT_V(6); PG8_BAR;
    }
    for (;;) {
        const bool has_next = S.next(ui + 1, nxt);
        const int K2n = has_next ? 2 * S.K(nxt, g) : K2c; const size_t hstepn = (size_t)HALF * K2n;
        const char* nA = has_next ? S.pA(nxt, g, 2 * hstepn) : cA; const char* nB = has_next ? S.pB(nxt, g, 2 * hstepn) : cB;
        for (int t = 0; t < ntc; t += 2) {
            const bool last = (t == ntc - 2);
            const int K2x = last ? K2n : K2c; const size_t hstepx = last ? hstepn : hstepc;
            const char* a1 = cA + (size_t)(t + 1) * kstep;
            const char* a2 = last ? nA : cA + (size_t)(t + 2) * kstep; const char* b2 = last ? nB : cB + (size_t)(t + 2) * kstep;
            const char* a3 = a2 + kstep; const char* b3 = b2 + kstep;
            if (last && has_next) S.a_ready(nxt);
            if constexpr (SP2) {
            PG8_LDB(B0, 0, 0); PG8_LDB(B1, 0, 1); PG8_SCHED; PG8_LDA(At, 0, 0); PG8_STAGE(PG8_SA(1, 1), a1 + hstepc, RA, K2c);
            PG8_WAIT_V(8); PG8_WAIT_L(0); PG8_BAR; PG8_MMA(0, 0, At, B0); PG8_MMA(0, 1, At, B1); PG8_BAR; PG8_SCHED;
            PG8_LDA(At, 0, 1); PG8_STAGE(PG8_SB(0, 0), b2, RB, K2x); PG8_STAGE(PG8_SB(0, 1), b2 + hstepx, RB, K2x); PG8_STAGE(PG8_SA(0, 0), a2, RA, K2x);
            PG8_WAIT_V(8); PG8_WAIT_L(0); PG8_BAR; PG8_MMA(1, 0, At, B0); PG8_MMA(1, 1, At, B1); PG8_BAR; PG8_SCHED;
            PG8_LDB(B0, 1, 0); PG8_LDB(B1, 1, 1); PG8_SCHED; PG8_LDA(At, 1, 0); PG8_STAGE(PG8_SA(0, 1), a2 + hstepx, RA, K2x);
            PG8_WAIT_V(8); PG8_WAIT_L(0); PG8_BAR; PG8_MMA(0, 0, At, B0); PG8_MMA(0, 1, At, B1); PG8_BAR; PG8_SCHED;
            PG8_LDA(At, 1, 1); PG8_STAGE(PG8_SB(1, 0), b3, RB, K2x); PG8_STAGE(PG8_SB(1, 1), b3 + hstepx, RB, K2x); PG8_STAGE(PG8_SA(1, 0), a3, RA, K2x);
            PG8_WAIT_V(8); PG8_WAIT_L(0); PG8_BAR; PG8_MMA(1, 0, At, B0); PG8_MMA(1, 1, At, B1); PG8_BAR; PG8_SCHED;
            } else {
            PG8_LDB(B0, 0, 0); PG8_SCHED; PG8_LDA(At, 0, 0); PG8_STAGE(PG8_SA(1, 1), a1 + hstepc, RA, K2c);
            PG8_WAIT_L(8); PG8_BAR; PG8_WAIT_L(0); PG8_MMA(0, 0, At, B0); PG8_BAR; PG8_SCHED;
            PG8_LDB(B1, 0, 1); PG8_STAGE(PG8_SB(0, 0), b2, RB, K2x);
            PG8_BAR; PG8_WAIT_L(0); PG8_MMA(0, 1, At, B1); PG8_BAR;
            PG8_LDA(At, 0, 1); PG8_STAGE(PG8_SA(0, 0), a2, RA, K2x);
            PG8_BAR; PG8_WAIT_L(0); PG8_MMA(1, 0, At, B0); PG8_BAR; PG8_SCHED;
            PG8_STAGE(PG8_SB(0, 1), b2 + hstepx, RB, K2x);
            PG8_WAIT_V(6); PG8_BAR; PG8_MMA(1, 1, At, B1); PG8_BAR;
            PG8_LDB(B0, 1, 0); PG8_SCHED; PG8_LDA(At, 1, 0); PG8_STAGE(PG8_SA(0, 1), a2 + hstepx, RA, K2x);
            PG8_WAIT_L(8); PG8_BAR; PG8_WAIT_L(0); PG8_MMA(0, 0, At, B0); PG8_BAR; PG8_SCHED;
            PG8_LDB(B1, 1, 1); PG8_STAGE(PG8_SB(1, 0), b3, RB, K2x);
            PG8_BAR; PG8_WAIT_L(0); PG8_MMA(0, 1, At, B1); PG8_BAR;
            PG8_LDA(At, 1, 1); PG8_STAGE(PG8_SA(1, 0), a3, RA, K2x);
            PG8_BAR; PG8_WAIT_L(0); PG8_MMA(1, 0, At, B0); PG8_BAR; PG8_SCHED;
            PG8_STAGE(PG8_SB(1, 1), b3 + hstepx, RB, K2x);
            PG8_WAIT_V(6); PG8_BAR; PG8_MMA(1, 1, At, B1); PG8_BAR;
            }
        }
        if constexpr (ALIGN_EPI) { if (wr == 0) PG8_BAR; }
        if constexpr (!Epi::AFTER_DRAIN) { E(acc, cur, wr, wc, fr, fq); S.done(cur); }
        if (!has_next) break;
        E.init(acc, nxt, wr, wc, fr, fq);
        cur = nxt; cA = nA; cB = nB; K2c = K2n; hstepc = hstepn; ntc = K2c / (2 * BK); ++ui;
        if constexpr (ALIGN_EPI) { if (wr == 1) PG8_BAR; }
    }
    PG8_WAIT_V(0);
    if constexpr (!ALIGN_EPI) { if (wr == 0) PG8_BAR; }
    PG8_BAR;
    if constexpr (Epi::AFTER_DRAIN) { E.fused(acc, cur, wr, wc, fr, fq, lds, wid, lane); S.done(cur); }
#undef PG8_SA
#undef PG8_SB
#undef PG8_STAGE
#undef PG8_LDA
#undef PG8_LDB
#undef PG8_MMA
#undef PG8_WAIT_V
#undef PG8_WAIT_L
#undef PG8_BAR
#undef PG8_SCHED
}
}
namespace att {
#define ALAS __attribute__((address_space(3)))
#define AGAS __attribute__((address_space(1)))
typedef unsigned short bf16_t;
typedef short bf16x8 __attribute__((ext_vector_type(8)));
typedef float f32x16 __attribute__((ext_vector_type(16)));
typedef unsigned u32x4 __attribute__((ext_vector_type(4)));
typedef unsigned u32x2 __attribute__((ext_vector_type(2)));
typedef float f32x2_t __attribute__((ext_vector_type(2))); typedef __bf16 bf16x2_t __attribute__((ext_vector_type(2)));
constexpr int SEQ = 16384;
constexpr int VROW = 144, KBYTES = 64 * 400, VBYTES = 128 * VROW;
constexpr int VBASE = 2 * KBYTES, ATT_LDS = 2 * KBYTES + 3 * VBYTES;
__device__ __forceinline__ unsigned cvtpk(float lo, float hi) { f32x2_t v = {lo, hi}; bf16x2_t b = __builtin_convertvector(v, bf16x2_t); return __builtin_bit_cast(unsigned, b); }
__device__ __forceinline__ int crow(int r, int hi) { return (r & 3) + 8 * (r >> 2) + 4 * hi; }


#define ASB() __builtin_amdgcn_sched_barrier(0)
#define DSR128(dst, addr, off) asm volatile("ds_read_b128 %0, %1 offset:%2" : "=v"(dst) : "v"(addr), "i"(off))
#define LGKM_WAIT2(n, x, y) do { if ((n) >= 4) asm volatile("s_waitcnt lgkmcnt(4)" : "+v"(x), "+v"(y)); else if ((n) == 2) asm volatile("s_waitcnt lgkmcnt(2)" : "+v"(x), "+v"(y)); else asm volatile("s_waitcnt lgkmcnt(0)" : "+v"(x), "+v"(y)); } while (0)
#define LGKM_WAIT1(n, x) do { if ((n) >= 3) asm volatile("s_waitcnt lgkmcnt(3)" : "+v"(x)); else if ((n) == 2) asm volatile("s_waitcnt lgkmcnt(2)" : "+v"(x)); else if ((n) == 1) asm volatile("s_waitcnt lgkmcnt(1)" : "+v"(x)); else asm volatile("s_waitcnt lgkmcnt(0)" : "+v"(x)); } while (0)
template <int DQK, bool NOLDS = false> __device__ __forceinline__ void qk_tile(const ALAS unsigned char* kb, const bf16x8 (&qr)[DQK / 16], f32x16& p0, f32x16& p1) {
    constexpr int KROW = DQK * 2 + 16, ND = DQK / 16;
    const unsigned kaddr = (unsigned)(size_t)kb;
    bf16x8 fa[3], fb[3];
    asm volatile("s_waitcnt lgkmcnt(0)" ::: "memory");
    DSR128(fa[0], kaddr, 0); DSR128(fb[0], kaddr, 32 * KROW);
    DSR128(fa[1], kaddr, 32); DSR128(fb[1], kaddr, 32 * KROW + 32);
    DSR128(fa[2], kaddr, 64); DSR128(fb[2], kaddr, 32 * KROW + 64);
    __builtin_amdgcn_s_setprio(1);
#pragma unroll
    for (int d0 = 0; d0 < ND; ++d0) {
        const int sl = d0 % 3, rem = ND - 1 - d0;
        if (NOLDS) { if (d0 == 0) LGKM_WAIT2(0, fa[sl], fb[sl]); } else LGKM_WAIT2(rem >= 2 ? 4 : 2 * rem, fa[sl], fb[sl]);
        p0 = __builtin_amdgcn_mfma_f32_32x32x16_bf16(fa[sl], qr[d0], p0, 0, 0, 0); p1 = __builtin_amdgcn_mfma_f32_32x32x16_bf16(fb[sl], qr[d0], p1, 0, 0, 0);
        if (!NOLDS && d0 + 3 < ND) { DSR128(fa[sl], kaddr, (d0 + 3) * 32); DSR128(fb[sl], kaddr, 32 * KROW + (d0 + 3) * 32); }
    }
    __builtin_amdgcn_s_setprio(0);
}
template <bool NOLDS = false> __device__ __forceinline__ void pv_tile(const ALAS unsigned char* vb, const bf16x8 (&pf)[4], f32x16 (&o)[4]) {
    const unsigned vaddr = (unsigned)(size_t)vb;
    bf16x8 vf[4];
    asm volatile("s_waitcnt lgkmcnt(0)" ::: "memory");
    DSR128(vf[0], vaddr, 0); DSR128(vf[1], vaddr, 32); DSR128(vf[2], vaddr, 64); DSR128(vf[3], vaddr, 96);
    __builtin_amdgcn_s_setprio(1);
#pragma unroll
    for (int j = 0; j < 16; ++j) {
        const int sl = j & 3, rem = 15 - j;
        if (NOLDS) { if (j == 0) LGKM_WAIT1(0, vf[sl]); } else if ((j & 1) == 0) LGKM_WAIT2(rem >= 3 ? 2 : 0, vf[sl], vf[sl + 1]);
        o[j >> 2] = __builtin_amdgcn_mfma_f32_32x32x16_bf16(vf[sl], pf[sl], o[j >> 2], 0, 0, 0);
        if (!NOLDS && j + 4 < 16) DSR128(vf[sl], vaddr, ((j + 4) >> 2) * 32 * VROW + ((j + 4) & 3) * 32);
    }
    __builtin_amdgcn_s_setprio(0);
}

__device__ __forceinline__ void gate_unit(ALAS unsigned char* lds, const bf16_t* Qh, const bf16_t* kmean_h, int qb, unsigned* cnt_h, unsigned* list_h) {
    constexpr int KROW = 272;
    if (qb == 0) return;
    int tid = threadIdx.x; asm volatile("" : "+v"(tid));
    const int lane = tid & 63, r32 = lane & 31, hi = lane >> 5, wid = __builtin_amdgcn_readfirstlane(tid >> 6);
    const int q = qb * 256 + wid * 32 + r32;
    bf16x8 qr[8];
    { const bf16_t* qp = Qh + (size_t)q * 1024 + 8 * hi;
#pragma unroll
      for (int d0 = 0; d0 < 8; ++d0) qr[d0] = *(const AGAS bf16x8*)(qp + 16 * d0); }
#pragma unroll
    for (int j = 0; j < 2; ++j) { const int idx = tid + 512 * j, row = idx >> 4, ch = idx & 15;
        *(ALAS u32x4*)(lds + row * KROW + ch * 16) = *(const AGAS u32x4*)(kmean_h + row * 128 + ch * 8); }
    __syncthreads();
    f32x16 p0, p1;
#pragma unroll
    for (int r = 0; r < 16; ++r) { p0[r] = 0.f; p1[r] = 0.f; }
    qk_tile<128>(lds + r32 * KROW + hi * 16, qr, p0, p1);
    float v1 = -3e38f, v2 = -3e38f, v3 = -3e38f; int i1 = -1, i2 = -1, i3 = -1;
#define TOP_INS(xv_, xn_) do { const float xv = (xv_); const int xn = (xn_); const bool g1 = xv > v1, g2 = xv > v2, g3 = xv > v3; \
        v3 = g2 ? v2 : (g3 ? xv : v3); i3 = g2 ? i2 : (g3 ? xn : i3); v2 = g1 ? v1 : (g2 ? xv : v2); i2 = g1 ? i1 : (g2 ? xn : i2); v1 = g1 ? xv : v1; i1 = g1 ? xn : i1; } while (0)
#pragma unroll
    for (int r = 0; r < 16; ++r) { const int n = crow(r, hi); TOP_INS(n < qb ? p0[r] : -3e38f, n); }
#pragma unroll
    for (int r = 0; r < 16; ++r) { const int n = 32 + crow(r, hi); TOP_INS(n < qb ? p1[r] : -3e38f, n); }
    { const float w1 = __shfl_xor(v1, 32), w2 = __shfl_xor(v2, 32), w3 = __shfl_xor(v3, 32); const int j1 = __shfl_xor(i1, 32), j2 = __shfl_xor(i2, 32), j3 = __shfl_xor(i3, 32);
      TOP_INS(w1, j1); TOP_INS(w2, j2); TOP_INS(w3, j3); }
#undef TOP_INS
    if (hi == 0) {
        if (i1 >= 0) { const unsigned pos = atomicAdd(cnt_h + i1, 1u); list_h[(size_t)i1 * SEQ + pos] = ((unsigned)q << 2) | 0u; }
        if (i2 >= 0) { const unsigned pos = atomicAdd(cnt_h + i2, 1u); list_h[(size_t)i2 * SEQ + pos] = ((unsigned)q << 2) | 1u; }
        if (i3 >= 0) { const unsigned pos = atomicAdd(cnt_h + i3, 1u); list_h[(size_t)i3 * SEQ + pos] = ((unsigned)q << 2) | 2u; }
    }
    __syncthreads();
}

template <int DQK, int MODE, int PROBE = 0>
__device__ __forceinline__ void unit(ALAS unsigned char* lds, const bf16_t* Q, int ldq, const bf16_t* K, int ldk, const bf16_t* VT, bf16_t* O, int qb,
                                     const unsigned* lst, int nvalid, bf16_t* part, float* ml, int h) {
    constexpr int KROW = DQK * 2 + 16, ND = DQK / 16, KCH = DQK / 8, KPT = 64 * KCH / 512;
    int tid = threadIdx.x; asm volatile("" : "+v"(tid));
    const int lane = tid & 63, r32 = lane & 31, hi = lane >> 5, wid = __builtin_amdgcn_readfirstlane(tid >> 6);
    const int q0 = qb * 256, qrel = wid * 32 + r32;
    const int T0 = MODE == 0 ? 0 : 4 * qb, NT = MODE == 0 ? 4 * qb + 4 : 4;
    u32x4 kst[KPT], vst[2];
    const int srow = tid >> 3, sc = tid & 7;
    unsigned kgo = (unsigned)(srow * ldk + 8 * sc), klo = (unsigned)(srow * KROW + 16 * sc);
    unsigned vgo = (unsigned)(srow * SEQ + 8 * sc), vlo = (unsigned)(srow * VROW + 32 * (sc >> 1) + 8 * (sc & 1));
#define ATT_LOAD(t) do { asm volatile("" : "+v"(kgo), "+v"(vgo)); const bf16_t* kt_ = K + (size_t)(64 * (T0 + (t))) * ldk; const bf16_t* vt_ = VT + 64 * (T0 + (t)); \
        _Pragma("unroll") for (int j = 0; j < KPT; ++j) kst[j] = *(const AGAS u32x4*)(kt_ + kgo + 64 * j); \
        vst[0] = *(const AGAS u32x4*)(vt_ + vgo); vst[1] = *(const AGAS u32x4*)(vt_ + (size_t)64 * SEQ + vgo); } while (0)
#define ATT_STORE(kb, vb) do { asm volatile("" : "+v"(klo), "+v"(vlo)); ALAS unsigned char* kb_ = lds + (kb) * KBYTES; ALAS unsigned char* vb_ = lds + VBASE + (vb) * VBYTES; \
        _Pragma("unroll") for (int j = 0; j < KPT; ++j) *(ALAS u32x4*)(kb_ + klo + 128 * j) = kst[j]; \
        _Pragma("unroll") for (int j = 0; j < 2; ++j) { ALAS unsigned char* vp = vb_ + vlo + j * 64 * VROW; \
            *(ALAS u32x2*)(vp) = (u32x2){vst[j].x, vst[j].y}; *(ALAS u32x2*)(vp + 16) = (u32x2){vst[j].z, vst[j].w}; } } while (0)
    ATT_LOAD(0);
    int qrow = q0 + qrel; unsigned slot = 0u; bool rowok = true;
    if (MODE == 1) { rowok = qrel < nvalid; const unsigned e = rowok ? *(const AGAS unsigned*)(lst + qrel) : 0u; qrow = (int)(e >> 2); slot = e & 3u; }
    const bool wave_ok = MODE == 1 ? (wid * 32 < nvalid) : true;
    bf16x8 qr[ND];
    { const bf16_t* qp = Q + (size_t)qrow * ldq + 8 * hi;
#pragma unroll
      for (int d0 = 0; d0 < ND; ++d0) qr[d0] = *(const AGAS bf16x8*)(qp + 16 * d0); }
    f32x16 o[4];
#pragma unroll
    for (int i = 0; i < 4; ++i)
#pragma unroll
        for (int r = 0; r < 16; ++r) o[i][r] = 0.f;
    float mrun = 0.f, lrun = 0.f; bool first = true;
    const float NINF = -__builtin_inff();

    ATT_STORE(0, 0);
    __syncthreads();
    const bool lag = wid >= 4; bool pend = false;
    int vcur = 0, vprev = 2;
    bf16x8 pf[4];
#pragma unroll
    for (int i = 0; i < 4; ++i) pf[i] = (bf16x8){0, 0, 0, 0, 0, 0, 0, 0};
    for (int t = 0; t < NT; ++t) {
        const int buf = t & 1;
        if (PROBE != 1 && PROBE != 4 && PROBE != 5 && PROBE != 6 && t + 1 < NT) ATT_LOAD(t + 1);
        if (pend) { pv_tile<PROBE == 6>(lds + VBASE + vprev * VBYTES + r32 * VROW + hi * 16, pf, o); pend = false; }
        const int jb = t - (NT - 4); const bool band = MODE == 1 ? false : jb >= 0;
        const bool active = PROBE == 2 ? false : (band ? (64 * jb <= 32 * wid + 31) : wave_ok);
        if (active) {
            f32x16 p0, p1;
#pragma unroll
            for (int r = 0; r < 16; ++r) { p0[r] = 0.f; p1[r] = 0.f; }
            qk_tile<DQK, PROBE == 6>(lds + buf * KBYTES + r32 * KROW + hi * 16, qr, p0, p1);
            if (band) { const int kvb = 64 * jb + 4 * hi;
#pragma unroll
                for (int r = 0; r < 16; ++r) { const int kv = kvb + (r & 3) + 8 * (r >> 2); if (kv > qrel) p0[r] = NINF; if (kv + 32 > qrel) p1[r] = NINF; } }
            if (PROBE != 4 && PROBE != 6) {
            float mxa = __builtin_fmaxf(__builtin_fmaxf(p0[0], p0[1]), p0[2]), mxb = __builtin_fmaxf(__builtin_fmaxf(p1[0], p1[1]), p1[2]);
            mxa = __builtin_fmaxf(__builtin_fmaxf(mxa, p0[3]), p1[3]);
#pragma unroll
            for (int r = 4; r < 16; r += 2) { mxa = __builtin_fmaxf(__builtin_fmaxf(mxa, p0[r]), p0[r + 1]); mxb = __builtin_fmaxf(__builtin_fmaxf(mxb, p1[r]), p1[r + 1]); }
            float mx = __builtin_fmaxf(mxa, mxb);
            { auto rr = __builtin_amdgcn_permlane32_swap(__float_as_uint(mx), __float_as_uint(mx), false, false); mx = __builtin_fmaxf(__uint_as_float(rr[0]), __uint_as_float(rr[1])); }
            const bool need = first ? (__builtin_fabsf(mx) > 16.0f) : (mx > mrun + 16.0f);
            if (__any(need)) { const float mnew = first ? mx : fmaxf(mrun, mx); const float al = __builtin_amdgcn_exp2f(mrun - mnew); lrun *= al;
                if (!first) {
#pragma unroll
                for (int i = 0; i < 4; ++i)
#pragma unroll
                    for (int r = 0; r < 16; ++r) o[i][r] *= al; }
                mrun = mnew; }
            first = false;
            float ps = 0.f;
            if (__all(mrun == 0.0f)) {
#pragma unroll
                for (int r = 0; r < 16; ++r) { p0[r] = __builtin_amdgcn_exp2f(p0[r]); p1[r] = __builtin_amdgcn_exp2f(p1[r]); ps += p0[r] + p1[r]; }
            } else {
#pragma unroll
                for (int r = 0; r < 16; ++r) { p0[r] = __builtin_amdgcn_exp2f(p0[r] - mrun); p1[r] = __builtin_amdgcn_exp2f(p1[r] - mrun); ps += p0[r] + p1[r]; }
            }
            lrun += ps;
            }
            { u32x4 w;
              w = (u32x4){cvtpk(p0[0], p0[1]), cvtpk(p0[2], p0[3]), cvtpk(p0[4], p0[5]), cvtpk(p0[6], p0[7])}; pf[0] = __builtin_bit_cast(bf16x8, w);
              w = (u32x4){cvtpk(p0[8], p0[9]), cvtpk(p0[10], p0[11]), cvtpk(p0[12], p0[13]), cvtpk(p0[14], p0[15])}; pf[1] = __builtin_bit_cast(bf16x8, w);
              w = (u32x4){cvtpk(p1[0], p1[1]), cvtpk(p1[2], p1[3]), cvtpk(p1[4], p1[5]), cvtpk(p1[6], p1[7])}; pf[2] = __builtin_bit_cast(bf16x8, w);
              w = (u32x4){cvtpk(p1[8], p1[9]), cvtpk(p1[10], p1[11]), cvtpk(p1[12], p1[13]), cvtpk(p1[14], p1[15])}; pf[3] = __builtin_bit_cast(bf16x8, w); }
            if (PROBE == 5) { o[0][0] += __builtin_bit_cast(float, (int)pf[0][0] | ((int)pf[3][1] << 16)); } else if (lag) pend = true; else pv_tile<PROBE == 6>(lds + VBASE + vcur * VBYTES + r32 * VROW + hi * 16, pf, o);
        }
        const int vnext = vcur == 2 ? 0 : vcur + 1;
        if (PROBE != 1 && PROBE != 4 && PROBE != 5 && PROBE != 6 && t + 1 < NT) ATT_STORE(buf ^ 1, vnext);
        if (PROBE != 3) __syncthreads();
        vprev = vcur; vcur = vnext;
    }
    if (pend) pv_tile<PROBE == 6>(lds + VBASE + vprev * VBYTES + r32 * VROW + hi * 16, pf, o);
    __syncthreads();
#undef ATT_LOAD
#undef ATT_STORE
    const float lt = lrun + __shfl_xor(lrun, 32);
    if (MODE == 0) {
        const float inv = 1.0f / lt;
        bf16_t* op = O + (size_t)qrow * 2048 + 4 * hi;
#pragma unroll
        for (int i = 0; i < 4; ++i)
#pragma unroll
            for (int g = 0; g < 4; ++g) { const u32x2 w = (u32x2){cvtpk(o[i][4 * g] * inv, o[i][4 * g + 1] * inv), cvtpk(o[i][4 * g + 2] * inv, o[i][4 * g + 3] * inv)}; *(AGAS u32x2*)(op + 32 * i + 8 * g) = w; }
    } else if (MODE == 1) {
        if (rowok) {
            const float inv = 1.0f / lt;
            const size_t pr = ((size_t)slot * SEQ + qrow) * 8 + h;
            bf16_t* op = part + pr * 128 + 64 * hi;
#pragma unroll
            for (int i = 0; i < 4; ++i)
#pragma unroll
                for (int g2 = 0; g2 < 2; ++g2) { const int r0 = 8 * g2;
                    const u32x4 w = (u32x4){cvtpk(o[i][r0] * inv, o[i][r0 + 1] * inv), cvtpk(o[i][r0 + 2] * inv, o[i][r0 + 3] * inv), cvtpk(o[i][r0 + 4] * inv, o[i][r0 + 5] * inv), cvtpk(o[i][r0 + 6] * inv, o[i][r0 + 7] * inv)};
                    *(AGAS u32x4*)(op + 16 * i + 8 * g2) = w; }
            if (hi == 0) { *(AGAS float*)(ml + pr * 2) = mrun; *(AGAS float*)(ml + pr * 2 + 1) = lt; }
        }
    } else {
        const int ns = qb < 3 ? qb : 3;
        float ms0 = -1e30f, ms1 = -1e30f, ms2 = -1e30f, ls0 = 0.f, ls1 = 0.f, ls2 = 0.f;
        if (ns > 0) { const size_t pr = ((size_t)0 * SEQ + qrow) * 8 + h; ms0 = *(const AGAS float*)(ml + pr * 2); ls0 = *(const AGAS float*)(ml + pr * 2 + 1); }
        if (ns > 1) { const size_t pr = ((size_t)1 * SEQ + qrow) * 8 + h; ms1 = *(const AGAS float*)(ml + pr * 2); ls1 = *(const AGAS float*)(ml + pr * 2 + 1); }
        if (ns > 2) { const size_t pr = ((size_t)2 * SEQ + qrow) * 8 + h; ms2 = *(const AGAS float*)(ml + pr * 2); ls2 = *(const AGAS float*)(ml + pr * 2 + 1); }
        const float M = fmaxf(fmaxf(mrun, ms0), fmaxf(ms1, ms2));
        const float w0 = __builtin_amdgcn_exp2f(mrun - M), w1 = ls0 * __builtin_amdgcn_exp2f(ms0 - M), w2 = ls1 * __builtin_amdgcn_exp2f(ms1 - M), w3 = ls2 * __builtin_amdgcn_exp2f(ms2 - M);
        const float inv = 1.0f / (w0 * lt + w1 + w2 + w3);
#pragma unroll
        for (int i = 0; i < 4; ++i)
#pragma unroll
            for (int r = 0; r < 16; ++r) o[i][r] *= w0;
#define MERGE_SLOT(sidx, wgt) do { const bf16_t* pp = part + (((size_t)(sidx) * SEQ + qrow) * 8 + h) * 128 + 64 * hi; \
            _Pragma("unroll") for (int i = 0; i < 4; ++i) _Pragma("unroll") for (int g2 = 0; g2 < 2; ++g2) { const u32x4 w = *(const AGAS u32x4*)(pp + 16 * i + 8 * g2); const int r0 = 8 * g2; \
                o[i][r0] += (wgt) * __uint_as_float(w.x << 16); o[i][r0 + 1] += (wgt) * __uint_as_float(w.x & 0xffff0000u); o[i][r0 + 2] += (wgt) * __uint_as_float(w.y << 16); o[i][r0 + 3] += (wgt) * __uint_as_float(w.y & 0xffff0000u); \
                o[i][r0 + 4] += (wgt) * __uint_as_float(w.z << 16); o[i][r0 + 5] += (wgt) * __uint_as_float(w.z & 0xffff0000u); o[i][r0 + 6] += (wgt) * __uint_as_float(w.w << 16); o[i][r0 + 7] += (wgt) * __uint_as_float(w.w & 0xffff0000u); } } while (0)
        if (ns > 0) MERGE_SLOT(0, w1);
        if (ns > 1) MERGE_SLOT(1, w2);
        if (ns > 2) MERGE_SLOT(2, w3);
#undef MERGE_SLOT
        bf16_t* op = O + (size_t)qrow * 2048 + 4 * hi;
#pragma unroll
        for (int i = 0; i < 4; ++i)
#pragma unroll
            for (int g = 0; g < 4; ++g) { const u32x2 w = (u32x2){cvtpk(o[i][4 * g] * inv, o[i][4 * g + 1] * inv), cvtpk(o[i][4 * g + 2] * inv, o[i][4 * g + 3] * inv)}; *(AGAS u32x2*)(op + 32 * i + 8 * g) = w; }
    }
}
}
#include <hip/hip_cooperative_groups.h>
namespace cg = cooperative_groups;
#define LAS __attribute__((address_space(3)))
typedef unsigned short bf16;
typedef unsigned v4u __attribute__((ext_vector_type(4)));
typedef unsigned v2u __attribute__((ext_vector_type(2)));
typedef float f32x4 __attribute__((ext_vector_type(4)));
constexpr int S = 16384, DM = 2048, DFF = 5632, INC = 5184;
constexpr size_t MiB = 1u << 20;
constexpr size_t WS_SSQC = 0, WS_SSQ1 = 64 * 1024, WS_SSQ2 = 128 * 1024, WS_SSQ3 = 192 * 1024, WS_KMEAN = 256 * 1024, WS_CNT = 384 * 1024, WS_PCNT = 392 * 1024  ;
constexpr size_t WS_LIST = 192 * MiB  , WS_PART = 256 * MiB  , WS_ML = 352 * MiB  ;
constexpr size_t WS_WIN = 2 * MiB, WS_WVMB = 19 * MiB, WS_WK = 23 * MiB, WS_WV = 24 * MiB, WS_WO = 25 * MiB, WS_WGU = 33 * MiB, WS_WD = 77 * MiB, WS_WPG = 99 * MiB, WS_WPE = 107 * MiB;
constexpr size_t WS_PB = 108 * MiB, WS_T128 = 116 * MiB, WS_T64 = 124 * MiB, WS_A0 = 128 * MiB, WS_HB = 192 * MiB;
constexpr size_t WS_QMLA = 256 * MiB, WS_KMLA = 304 * MiB, WS_VTMLA = 352 * MiB, WS_CKV = 384 * MiB, WS_QMB = 400 * MiB, WS_KMB = 432 * MiB, WS_VTMB = 464 * MiB, WS_FF = 256 * MiB, WS_END = 496 * MiB;
constexpr int NWIN = 4352;
constexpr int LDS_BYTES = 133120, MISC_OFF = 131072;
constexpr size_t WS_BAR = 512 * 1024, WS_DUMMY = 448 * 1024;

__device__ const float INV128[64] = {1.000000000e+00f, 8.659643531e-01f, 7.498942614e-01f, 6.493816376e-01f, 5.623413324e-01f, 4.869675338e-01f, 4.216965139e-01f, 3.651741147e-01f, 3.162277639e-01f, 2.738419771e-01f, 2.371373773e-01f, 2.053525001e-01f, 1.778279394e-01f, 1.539926529e-01f, 1.333521307e-01f, 1.154782027e-01f, 1.000000015e-01f, 8.659642935e-02f, 7.498941571e-02f, 6.493816525e-02f, 5.623413250e-02f, 4.869675264e-02f, 4.216965288e-02f, 3.651741147e-02f, 3.162277490e-02f, 2.738419734e-02f, 2.371373773e-02f, 2.053525113e-02f, 1.778279431e-02f, 1.539926510e-02f, 1.333521493e-02f, 1.154782064e-02f, 9.999999776e-03f, 8.659643121e-03f, 7.498941850e-03f, 6.493816152e-03f, 5.623413250e-03f, 4.869675264e-03f, 4.216964822e-03f, 3.651741194e-03f, 3.162277630e-03f, 2.738419687e-03f, 2.371373586e-03f, 2.053524833e-03f, 1.778279431e-03f, 1.539926510e-03f, 1.333521446e-03f, 1.154781901e-03f, 1.000000047e-03f, 8.659643354e-04f, 7.498942432e-04f, 6.493816618e-04f, 5.623413017e-04f, 4.869675322e-04f, 4.216965172e-04f, 3.651741426e-04f, 3.162277571e-04f, 2.738419571e-04f, 2.371373703e-04f, 2.053525095e-04f, 1.778279402e-04f, 1.539926452e-04f, 1.333521504e-04f, 1.154782003e-04f};
__device__ const float INV64[32] = {1.000000000e+00f, 7.498942614e-01f, 5.623413324e-01f, 4.216965139e-01f, 3.162277639e-01f, 2.371373773e-01f, 1.778279394e-01f, 1.333521307e-01f, 1.000000015e-01f, 7.498941571e-02f, 5.623413250e-02f, 4.216965288e-02f, 3.162277490e-02f, 2.371373773e-02f, 1.778279431e-02f, 1.333521493e-02f, 9.999999776e-03f, 7.498941850e-03f, 5.623413250e-03f, 4.216964822e-03f, 3.162277630e-03f, 2.371373586e-03f, 1.778279431e-03f, 1.333521446e-03f, 1.000000047e-03f, 7.498942432e-04f, 5.623413017e-04f, 4.216965172e-04f, 3.162277571e-04f, 2.371373703e-04f, 1.778279402e-04f, 1.333521504e-04f};

__device__ __forceinline__ unsigned f2bf(float f) { unsigned u = __builtin_bit_cast(unsigned, f); return (u + 0x7fffu + ((u >> 16) & 1u)) >> 16; }
__device__ __forceinline__ unsigned pk2(float lo, float hi) { return f2bf(lo) | (f2bf(hi) << 16); }
__device__ __forceinline__ float wave_sum(float v) {
#pragma unroll
    for (int o = 1; o < 64; o <<= 1) v += __shfl_xor(v, o);
    return v;
}
__device__ __forceinline__ void sincos_acc(float ang, float& c, float& s) {
    double t = (double)ang * 0.15915494309189535; t -= rint(t); const double r = t * 6.283185307179586, r2 = r * r;
    double sp = 1.0, cp = 1.0;
#pragma unroll
    for (int k = 13; k >= 1; --k) { sp = 1.0 - sp * r2 * (1.0 / (double)((2 * k) * (2 * k + 1))); cp = 1.0 - cp * r2 * (1.0 / (double)((2 * k - 1) * (2 * k))); }
    s = (float)(r * sp); c = (float)cp;
}
__device__ __forceinline__ void transpose_item(const float* W, int ldw, int col0, int K, int k0, bf16* WT, int dstrow0, const float* gain, bool zero, LAS float* scr, int lane) {
    f32x4 v[8];
    const int kr = lane >> 3, n4 = 4 * (lane & 7);
#pragma unroll
    for (int i = 0; i < 8; ++i) v[i] = zero ? (f32x4){0.f, 0.f, 0.f, 0.f} : *(const f32x4*)(W + (size_t)(k0 + kr + 8 * i) * ldw + col0 + n4);
    if (gain) {
#pragma unroll
        for (int i = 0; i < 8; ++i) v[i] = v[i] * gain[k0 + kr + 8 * i]; }
#pragma unroll
    for (int i = 0; i < 8; ++i) { LAS float* d = scr + (kr + 8 * i) * 33 + n4; d[0] = v[i].x; d[1] = v[i].y; d[2] = v[i].z; d[3] = v[i].w; }
    asm volatile("s_waitcnt lgkmcnt(0)" ::: "memory");
    const int c = lane & 7;
#pragma unroll
    for (int j = 0; j < 4; ++j) { const int n = (lane >> 3) + 8 * j; const LAS float* s = scr + (8 * c) * 33 + n;
        v4u o; o.x = pk2(s[0 * 33], s[1 * 33]); o.y = pk2(s[2 * 33], s[3 * 33]); o.z = pk2(s[4 * 33], s[5 * 33]); o.w = pk2(s[6 * 33], s[7 * 33]);
        *(v4u*)(WT + (size_t)(dstrow0 + n) * K + k0 + 8 * c) = o; }
    asm volatile("s_waitcnt lgkmcnt(0)" ::: "memory");
}
__device__ __forceinline__ int win_src(int g) {
    const int t = g >> 3, cgp = g & 7;
    if (t < 4) return (2 * t + (cgp >> 2)) * 192 + (cgp & 3) * 32;
    if (t < 6) return (4 * (t - 4) + (cgp & 3)) * 192 + 128 + 32 * (cgp >> 2);
    if (t < 8) return 1536 + 256 * (t - 6) + 32 * cgp;
    if (t < 16) { const int base = t < 12 ? 2112 : 3136, uu = t < 12 ? t - 8 : t - 12, half = cgp >> 2, cc = (cgp & 3) * 32; return base + (2 * uu + (cc >> 6)) * 128 + 64 * half + (cc & 63); }
    return (cgp & 3) == 0 ? 2048 + 32 * (cgp >> 2) : -1;
}

typedef __attribute__((address_space(1))) unsigned gu32;
#define XB_TMO      128
#define XB_XCNT(j)  (256  + 64 * (j))
#define XB_XSUB(j)  (1280 + 64 * (j))
#define XB_XGEN(j)  (2304 + 64 * (j))
#define XB_TOP      3328
#define XB_TOPGEN   3392
#define XCD_BAR_WORDS 3456
#define XB_SPIN_CAP (1u << 18)

__device__ __forceinline__ unsigned xb_ld(unsigned* p)              { return __hip_atomic_load(p, __ATOMIC_RELAXED, __HIP_MEMORY_SCOPE_AGENT); }
__device__ __forceinline__ unsigned xb_add(unsigned* p, unsigned v) { return __hip_atomic_fetch_add(p, v, __ATOMIC_RELAXED, __HIP_MEMORY_SCOPE_AGENT); }
__device__ __forceinline__ unsigned xb_xcc_id() { return (unsigned)__builtin_amdgcn_s_getreg((3 << 11) | 20) & 0xFu; }
#define XB_SPIN(cond, bar) do { unsigned _sp = 0; while (cond) { __builtin_amdgcn_s_sleep(1); \
    if ((++_sp & 255u) == 0u) { if (xb_ld(&(bar)[XB_TMO])) break; if (_sp > XB_SPIN_CAP) { atomicAdd(&(bar)[XB_TMO], 1u); break; } } } } while (0)

struct XcdBarrier {
    unsigned* bar; unsigned x;
    volatile LAS unsigned* st;
};

__device__ __forceinline__ XcdBarrier xcd_barrier_post(unsigned* bar, volatile LAS unsigned* st) {
    XcdBarrier b; b.bar = bar; b.x = xb_xcc_id(); b.st = st;
    if (threadIdx.x == 0) (void)xb_add(&bar[XB_XCNT(b.x)], 1u);
    return b;
}
__device__ __forceinline__ void xcd_barrier_complete(unsigned* bar, unsigned x, unsigned& nloc, unsigned& nx) {
    const unsigned G = gridDim.x * gridDim.y * gridDim.z;
    unsigned sum, cnt, mine, sp = 0u;
    for (;;) {
        sum = 0u; cnt = 0u; mine = 0u;
#pragma unroll
        for (unsigned j = 0; j < 16; ++j) { const unsigned c = xb_ld(&bar[XB_XCNT(j)]); sum += c; cnt += (c > 0u) ? 1u : 0u; mine = (j == x) ? c : mine; }
        if (sum == G) break;
        __builtin_amdgcn_s_sleep(1);
        if ((++sp & 255u) == 0u) { if (xb_ld(&bar[XB_TMO])) break; if (sp > XB_SPIN_CAP) { atomicAdd(&bar[XB_TMO], 1u); break; } }
    }
    nloc = mine > 0u ? mine : 1u; nx = cnt > 0u ? cnt : 1u;
}

__device__ __forceinline__ void xcd_barrier(const XcdBarrier& b) {
    asm volatile("s_waitcnt vmcnt(0)" ::: "memory");
    __syncthreads();
    if (threadIdx.x == 0) {
        unsigned* bar = b.bar;
        __builtin_amdgcn_s_waitcnt(0);
        unsigned nloc = b.st[0], nx = b.st[1];
        if (nloc == 0u) { xcd_barrier_complete(bar, b.x, nloc, nx); b.st[0] = nloc; b.st[1] = nx; }
        const unsigned old = xb_add(&bar[XB_XSUB(b.x)], 1u);
        const unsigned gen = old / nloc;
        if (old + 1u == (gen + 1u) * nloc) {
            __builtin_amdgcn_fence(__ATOMIC_RELEASE, "agent");
            asm volatile("s_waitcnt vmcnt(0)" ::: "memory");
            const unsigned og = xb_add(&bar[XB_TOP], 1u);
            const unsigned tg = og / nx;
            if (og + 1u == (tg + 1u) * nx) xb_add(&bar[XB_TOPGEN], 1u);
            else XB_SPIN(xb_ld(&bar[XB_TOPGEN]) == tg, bar);
            __builtin_amdgcn_fence(__ATOMIC_ACQUIRE, "agent");
            xb_add(&bar[XB_XGEN(b.x)], 1u);
            asm volatile("s_waitcnt vmcnt(0)" ::: "memory");
        } else {
            XB_SPIN(xb_ld(&bar[XB_XGEN(b.x)]) == gen, bar);
            __builtin_amdgcn_fence(__ATOMIC_ACQUIRE, "agent");
            asm volatile("s_waitcnt vmcnt(0)" ::: "memory");
        }
    }
    __syncthreads();
}

struct Args { const float* in[16]; float* out; unsigned char* ws; int ph_lo, ph_hi; };
enum { I_X = 0, I_P, I_POS, I_ANORM, I_WIN, I_KVNORM, I_WUKV, I_WO, I_FNORM, I_WG, I_WU, I_WD, I_PNORM, I_WPG, I_WPE, I_FINAL };

template <class Epi> __device__ __forceinline__ void run_gemm(LAS unsigned char* lds, const bf16* A, const bf16* Bt, int M, int N, int K, const Epi& E) {
    asm volatile("" : "+s"(M), "+s"(N), "+s"(K));
    pg8::Gemm g{A, Bt, M, N, K}; pg8::StaticOrder So; So.init(M, N, (int)gridDim.x, (int)blockIdx.x);
    pg8::gemm_phase<Epi, pg8::StaticOrder, true, true>(lds, g, So, E);
}

template <class E0, class E1> __device__ __forceinline__ void run_gemm2(LAS unsigned char* lds, const bf16* A0_, const bf16* B0_, int M0, int N0, const bf16* A1_, const bf16* B1_, int M1, int N1, int K, const E0& e0, const E1& e1) {
    asm volatile("" : "+s"(M0), "+s"(N0), "+s"(M1), "+s"(N1), "+s"(K));
    pg8::Gemm g{A0_, B0_, M0, N0, K}; pg8::DualOrder So; So.init(M0, N0, M1, N1, (int)gridDim.x, (int)blockIdx.x, A1_, B1_);
    pg8::EpiDual<E0, E1> E{e0, e1};
    pg8::gemm_phase<pg8::EpiDual<E0, E1>, pg8::DualOrder, true, true>(lds, g, So, E);
}
template <class E0, class E1, class E2> __device__ __forceinline__ void run_gemm3(LAS unsigned char* lds, const bf16* A0_, const bf16* B0_, int M0, int N0, int K0, const bf16* A1_, const bf16* B1_, int M1, int N1, int K1,
                                                                               const bf16* A2_, const bf16* B2_, int M2, int N2, int K2, const E0& e0, const E1& e1, const E2& e2) {
    asm volatile("" : "+s"(M0), "+s"(N0), "+s"(K0), "+s"(M1), "+s"(N1), "+s"(K1), "+s"(M2), "+s"(N2), "+s"(K2));
    pg8::Gemm g{A0_, B0_, M0, N0, K0}; pg8::TriOrder So; So.init(M0, N0, M1, N1, M2, N2, (int)gridDim.x, (int)blockIdx.x, A1_, B1_, K1, A2_, B2_, K2);
    pg8::EpiTri<E0, E1, E2> E{e0, e1, e2};
    pg8::gemm_phase<pg8::EpiTri<E0, E1, E2>, pg8::TriOrder, true, true>(lds, g, So, E);
}
__global__ void __launch_bounds__(512) fwd(Args a) {
    extern __shared__ __attribute__((aligned(16))) unsigned char lds_raw[];
    LAS unsigned char* lds = (LAS unsigned char*)lds_raw;
    const int tid = threadIdx.x, lane = tid & 63, wave = __builtin_amdgcn_readfirstlane(tid >> 6);
    const int G = gridDim.x, bx = blockIdx.x;
    const int vcu = (G % 8 == 0) ? (bx % 8) * (G / 8) + bx / 8 : bx;
#define PTRS \
        unsigned char* ws = a.ws; asm volatile("" : "+s"(ws));     \
        float* ssqc = (float*)(ws + WS_SSQC); float* ssq1 = (float*)(ws + WS_SSQ1); float* ssq2 = (float*)(ws + WS_SSQ2); float* ssq3 = (float*)(ws + WS_SSQ3); bf16* kmean = (bf16*)(ws + WS_KMEAN); \
        bf16 *Win_t = (bf16*)(ws + WS_WIN), *Wvmb_t = (bf16*)(ws + WS_WVMB), *Wk_t = (bf16*)(ws + WS_WK), *Wv_t = (bf16*)(ws + WS_WV), *Wo_t = (bf16*)(ws + WS_WO), *Wgu_t = (bf16*)(ws + WS_WGU), *Wd_t = (bf16*)(ws + WS_WD), *Wpg_t = (bf16*)(ws + WS_WPG), *Wpe_t = (bf16*)(ws + WS_WPE); \
        bf16 *pb = (bf16*)(ws + WS_PB), *A0 = (bf16*)(ws + WS_A0), *hb = (bf16*)(ws + WS_HB), *qmla = (bf16*)(ws + WS_QMLA), *kmla = (bf16*)(ws + WS_KMLA), *vtmla = (bf16*)(ws + WS_VTMLA), *ckv = (bf16*)(ws + WS_CKV), \
             *qmb = (bf16*)(ws + WS_QMB), *kmb = (bf16*)(ws + WS_KMB), *vtmb = (bf16*)(ws + WS_VTMB), *ff = (bf16*)(ws + WS_FF); \
        float* tab128 = (float*)(ws + WS_T128); float* tab64 = (float*)(ws + WS_T64); unsigned* mcnt = (unsigned*)(ws + WS_CNT); unsigned* mlist = (unsigned*)(ws + WS_LIST); bf16* mpart = (bf16*)(ws + WS_PART); float* mml = (float*)(ws + WS_ML); \
        (void)mcnt; (void)mlist; (void)mpart; (void)mml; \
        (void)ssqc; (void)ssq1; (void)ssq2; (void)ssq3; (void)kmean; (void)Win_t; (void)Wvmb_t; (void)Wk_t; (void)Wv_t; (void)Wo_t; (void)Wgu_t; (void)Wd_t; (void)Wpg_t; (void)Wpe_t; (void)pb; (void)A0; (void)hb; (void)qmla; (void)kmla; (void)vtmla; (void)ckv; (void)qmb; (void)kmb; (void)vtmb; (void)ff; (void)tab128; (void)tab64;
    const int lo = a.ph_lo, hi = a.ph_hi;
    if (tid < 2) ((LAS unsigned*)(lds + MISC_OFF))[tid] = 0u;
    __syncthreads();
    XcdBarrier xbar = xcd_barrier_post((unsigned*)(a.ws + WS_BAR), (volatile LAS unsigned*)(lds + MISC_OFF));
#ifndef PH_MASK
#define PH_MASK 0x7ff
#endif
#define IN(k) (((PH_MASK >> (k)) & 1) && lo <= (k) && (k) < hi)
#define SEAM(k) do { if (IN(k) && IN((k) + 1)) { if (a.ph_lo < 0) cg::this_grid().sync();     \
        xcd_barrier(xbar); } } while (0)
    const int gw = vcu * 8 + wave, NGW = G * 8, gt = bx * 512 + tid, NGT = G * 512;

    if (IN(0)) { PTRS
#ifdef DUP_P0
      for (int dup_ = 0; dup_ < 2; ++dup_) {
#else
      {
#endif
        LAS float* scr = (LAS float*)(lds + wave * 16384);
        constexpr int C0 = (NWIN / 32) * 32, C1 = C0 + 32 * 32, C2 = C1 + 32 * 8, C3 = C2 + 32 * 8, C4 = C3 + 64 * 32, C5 = C4 + 352 * 32, C6 = C5 + 64 * 88, C7 = C6 + 64 * 32, C8 = C7 + 64 * 4;
        for (int it = gw; it < C8; it += NGW) {
            if (it < C0) { const int g = it % 136, kb = it / 136, src = win_src(g); transpose_item(a.in[I_WIN], INC, src < 0 ? 0 : src, 2048, 64 * kb, Win_t, 32 * g, nullptr, src < 0, scr, lane); }
            else if (it < C1) { const int r = it - C0, g = r % 32, kb = r / 32; transpose_item(a.in[I_WIN], INC, 4160 + 32 * g, 2048, 64 * kb, Wvmb_t, 32 * g, nullptr, false, scr, lane); }
            else if (it < C2) { const int r = it - C1, g = r % 32, kb = r / 32; transpose_item(a.in[I_WUKV], 2048, (g >> 2) * 256 + 32 * (g & 3), 512, 64 * kb, Wk_t, 32 * g, a.in[I_KVNORM], false, scr, lane); }
            else if (it < C3) { const int r = it - C2, g = r % 32, kb = r / 32; transpose_item(a.in[I_WUKV], 2048, (g >> 2) * 256 + 128 + 32 * (g & 3), 512, 64 * kb, Wv_t, 32 * g, a.in[I_KVNORM], false, scr, lane); }
            else if (it < C4) { const int r = it - C3, g = r % 64, kb = r / 64; transpose_item(a.in[I_WO], 2048, 32 * g, 2048, 64 * kb, Wo_t, 32 * g, nullptr, false, scr, lane); }
            else if (it < C5) { const int r = it - C4, g = r % 352, kb = r / 352, pn = g >> 3, bj = (g >> 2) & 1, cc = (g & 3) * 32; transpose_item(bj ? a.in[I_WU] : a.in[I_WG], DFF, 128 * pn + cc, 2048, 64 * kb, Wgu_t, 32 * g, a.in[I_FNORM], false, scr, lane); }
            else if (it < C6) { const int r = it - C5, g = r % 64, kb = r / 64; transpose_item(a.in[I_WD], 2048, 32 * g, DFF, 64 * kb, Wd_t, 32 * g, nullptr, false, scr, lane); }
            else if (it < C7) { const int r = it - C6, g = r % 64, kb = r / 64; transpose_item(a.in[I_WPG], 2048, 32 * g, 2048, 64 * kb, Wpg_t, 32 * g, a.in[I_PNORM], false, scr, lane); }
            else { const int r = it - C7, g = r % 64, kb = r / 64; transpose_item(a.in[I_WPE], 2048, 32 * g, 256, 64 * kb, Wpe_t, 32 * g, nullptr, false, scr, lane); }
        }
        { const float* gn = a.in[I_ANORM];
          for (int m = gw; m < S; m += NGW) { const f32x4* xr = (const f32x4*)(a.in[I_X] + (size_t)m * DM) + lane; f32x4 v[8]; float s = 0.f;
#pragma unroll
              for (int j = 0; j < 8; ++j) { v[j] = xr[64 * j]; s += (v[j].x * v[j].x + v[j].y * v[j].y) + (v[j].z * v[j].z + v[j].w * v[j].w); }
              const float rstd = 1.0f / sqrtf(wave_sum(s) * (1.0f / DM) + 1e-6f);
              v2u* o8 = (v2u*)(A0 + (size_t)m * DM) + lane;
#pragma unroll
              for (int j = 0; j < 8; ++j) { const f32x4 gg = ((const f32x4*)gn)[lane + 64 * j]; o8[64 * j] = (v2u){pk2(v[j].x * rstd * gg.x, v[j].y * rstd * gg.y), pk2(v[j].z * rstd * gg.z, v[j].w * rstd * gg.w)}; } } }
        for (int i = gt; i < S * 256 / 4; i += NGT) { const f32x4 v = ((const f32x4*)a.in[I_P])[i]; ((v2u*)pb)[i] = (v2u){pk2(v.x, v.y), pk2(v.z, v.w)}; }
        { const int* pos = (const int*)a.in[I_POS];
          for (int i = gt; i < S * 96; i += NGT) { const int row = i / 96, j = i % 96; const float pf = (float)pos[row]; float c, s;
              if (j < 64) { sincos_acc(pf * INV128[j], c, s); tab128[((size_t)row * 64 + j) * 2] = c; tab128[((size_t)row * 64 + j) * 2 + 1] = s; }
              else { sincos_acc(pf * INV64[j - 64], c, s); tab64[((size_t)row * 32 + (j - 64)) * 2] = c; tab64[((size_t)row * 32 + (j - 64)) * 2 + 1] = s; } } }
        for (int i = gt; i < 4 * S; i += NGT) ssqc[i] = 0.f;
        for (int i = gt; i < 512; i += NGT) mcnt[i] = 0u;
        for (int i = gt; i < 64 * 64; i += NGT) ((unsigned*)(ws + WS_PCNT))[i] = 0u;
      }
    }
    SEAM(0);
    if (IN(1)) { PTRS
        pg8::EpiProj E{qmla, kmla, ckv, qmb, kmb, ssqc, tab128, tab64};
        pg8::EpiT<false> Et{vtmb, S, nullptr, 0.f};
        pg8::EpiP Ep{(bf16*)a.out};
        run_gemm3(lds, A0, Win_t, S, NWIN, 2048, Wvmb_t, A0, 1024, S, 2048, pb, Wpe_t, S, 2048, 256, E, Et, Ep);
    }
    SEAM(1);
    if (IN(2)) { PTRS
        pg8::EpiKnope Ek{kmla, ssqc};
        pg8::EpiT<true> Et{vtmla, S, ssqc, 1.0f / 512.0f};
        run_gemm2(lds, ckv, Wk_t, S, 1024, Wv_t, ckv, 1024, S, 512, Ek, Et);
#ifdef DUP_P2
        run_gemm2(lds, ckv, Wk_t, S, 1024, Wv_t, ckv, 1024, S, 512, Ek, Et);
#endif
#ifdef DUP_KMEAN
      for (int dup_ = 0; dup_ < 2; ++dup_)
#endif
      {
        for (int i = gt; i < 64 * 1024; i += NGT) { const int n = i >> 10, col = i & 1023; const bf16* kp = kmb + (size_t)(256 * n) * 1024 + col; float s = 0.f;
            for (int r = 0; r < 256; ++r) s += pg8::bf2f(kp[(size_t)r * 1024]);
            kmean[((col >> 7) * 64 + n) * 128 + (col & 127)] = (bf16)f2bf(s * (1.0f / 256.0f)); }
      }
    }
    SEAM(2);
    if (IN(3)) { PTRS
        for (int v = vcu; v < 256; v += G) { const int h = v >> 5, s = v & 31;
#pragma unroll 1
            for (int i = 0; i < 2; ++i) { const int qb = i == 0 ? 63 - s : s;
                att::gate_unit(lds, qmb + h * 128, kmean + h * 64 * 128, qb, mcnt + h * 64, mlist + (size_t)h * 64 * S); }
#ifdef PROBE_MLA
#pragma unroll 1
            for (int i = 0; i < 2; ++i) { const int qb = i == 0 ? 63 - s : s;
                att::unit<192, 0, PROBE_MLA>(lds, qmla + h * 192, 1536, kmla + h * 192, 1536, vtmla + (size_t)h * 128 * S, A0 + h * 128, qb, nullptr, 0, nullptr, nullptr, h); }
#endif
#pragma unroll 1
            for (int i = 0; i < 2; ++i) { const int qb = i == 0 ? 63 - s : s;
                att::unit<192, 0>(lds, qmla + h * 192, 1536, kmla + h * 192, 1536, vtmla + (size_t)h * 128 * S, A0 + h * 128, qb, nullptr, 0, nullptr, nullptr, h); } }
    }
    SEAM(3);
    if (IN(4)) { PTRS
        LAS unsigned* pre = (LAS unsigned*)(lds + att::ATT_LDS);
        LAS unsigned* cntl = pre + 512;
        { const unsigned c = mcnt[tid]; cntl[tid] = c; unsigned vsum = (c + 255u) >> 8; pre[tid] = vsum; __syncthreads();
          for (int off = 1; off < 512; off <<= 1) { const unsigned add = tid >= off ? pre[tid - off] : 0u; __syncthreads(); vsum += add; pre[tid] = vsum; __syncthreads(); } }
        const int total = (int)pre[511];
#ifdef DUP_P4
      for (int dup_ = 0; dup_ < 2; ++dup_)
#endif
#pragma unroll 1
        for (int g = vcu; g < total; g += G) {
            int lo_ = 0, hi_ = 511;
            while (lo_ < hi_) { const int mid = (lo_ + hi_) >> 1; if ((int)pre[mid] > g) hi_ = mid; else lo_ = mid + 1; }
            const int li = __builtin_amdgcn_readfirstlane(lo_), c = g - (li ? (int)pre[li - 1] : 0), h = li >> 6, n = li & 63;
            const int cn = (int)cntl[li] - 256 * c, nvalid = cn < 256 ? cn : 256;
            att::unit<128, 1>(lds, qmb + h * 128, 1024, kmb + h * 128, 1024, vtmb + (size_t)h * 128 * S, nullptr, n, mlist + ((size_t)li * S + 256 * c), nvalid, mpart, mml, h);
        }
    }
    SEAM(4);
    if (IN(5)) { PTRS
        for (int v = vcu; v < 256; v += G) { const int h = v >> 5, s = v & 31;
#ifdef DUP_P5
#pragma unroll 1
            for (int i = 0; i < 4; ++i) { const int qb = (i & 1) == 0 ? 63 - s : s;
#else
#pragma unroll 1
            for (int i = 0; i < 2; ++i) { const int qb = i == 0 ? 63 - s : s;
#endif
                att::unit<128, 2>(lds, qmb + h * 128, 1024, kmb + h * 128, 1024, vtmb + (size_t)h * 128 * S, A0 + 1024 + h * 128, qb, nullptr, 0, mpart, mml, h); } }
    }
    SEAM(5);
#ifdef DUP_SYNC
    for (int dup_ = 0; dup_ < 10; ++dup_) xcd_barrier(xbar);
#endif
    if (IN(6)) { PTRS
#ifdef DUP_WO_NOEPI
        { pg8::EpiNone En{(float*)(ws + WS_DUMMY)}; run_gemm(lds, A0, Wo_t, S, 2048, 2048, En); }
#endif
#ifdef DUP_WO
        { pg8::EpiRes<true> Ed{a.in[I_X], hb, (float*)(ws + WS_DUMMY)}; run_gemm(lds, A0, Wo_t, S, 2048, 2048, Ed); }
#endif
        pg8::EpiRes<true> E{a.in[I_X], hb, ssq1}; run_gemm(lds, A0, Wo_t, S, 2048, 2048, E); }
    SEAM(6);
    if (IN(7)) { PTRS
#ifndef NO_SWI
        pg8::EpiSwiglu E{ff, ssq1}; run_gemm(lds, hb, Wgu_t, S, 2 * DFF, 2048, E);
#ifdef DUP_SWI
        run_gemm(lds, hb, Wgu_t, S, 2 * DFF, 2048, E);
#endif
#endif
    }
    SEAM(7);
    if (IN(8)) { PTRS pg8::EpiRes<false> E{hb, hb, ssq2}; run_gemm(lds, ff, Wd_t, S, 2048, DFF, E); }
    SEAM(8);
#ifndef FUSED_FINAL
#define FUSED_FINAL 1
#endif
    const bool fusedfin = FUSED_FINAL && (G == 256) && IN(9) && IN(10);
    if (IN(9)) { PTRS
        if (fusedfin) {
            int M_ = S, N_ = 2048, K_ = 2048; asm volatile("" : "+s"(M_), "+s"(N_), "+s"(K_));
            pg8::Gemm g{hb, Wpg_t, M_, N_, K_}; pg8::PanelOrder So{(int)blockIdx.x};
            pg8::EpiPleFused E{hb, (const bf16*)a.out, ssq2, ssq3, (unsigned*)(ws + WS_PCNT), a.out, a.in[I_FINAL]};
            pg8::gemm_phase<pg8::EpiPleFused, pg8::PanelOrder, true, true>(lds, g, So, E);
        } else { pg8::EpiPle E{hb, ff  , (const bf16*)a.out, ssq2, ssq3}; run_gemm(lds, hb, Wpg_t, S, 2048, 2048, E); }
    }
    if (!fusedfin) {
    SEAM(9);
    if (IN(10)) { PTRS const float* gn = a.in[I_FINAL];
        for (int m = gw; m < S; m += NGW) { const float r = 1.0f / sqrtf(ssq3[m] * (1.0f / DM) + 1e-6f); const v4u* xr = (const v4u*)(ff + (size_t)m * DM) + lane; f32x4* yr = (f32x4*)(a.out + (size_t)m * DM) + 2 * lane;
#pragma unroll
            for (int j = 0; j < 4; ++j) { const v4u w = xr[64 * j]; const f32x4 g0 = ((const f32x4*)gn)[2 * lane + 128 * j], g1 = ((const f32x4*)gn)[2 * lane + 128 * j + 1];
                f32x4 lo4 = (f32x4){__uint_as_float(w.x << 16), __uint_as_float(w.x & 0xffff0000u), __uint_as_float(w.y << 16), __uint_as_float(w.y & 0xffff0000u)};
                f32x4 hi4 = (f32x4){__uint_as_float(w.z << 16), __uint_as_float(w.z & 0xffff0000u), __uint_as_float(w.w << 16), __uint_as_float(w.w & 0xffff0000u)};
                yr[128 * j] = lo4 * r * g0; yr[128 * j + 1] = hi4 * r * g1; } } }
    }
#undef IN
#undef SEAM
}

#ifndef N_LAUNCH_MODE
#define N_LAUNCH_MODE 1
#endif
extern "C" void kernel_launch(void* const* d_in, const int* in_sizes, int n_in, void* d_out, int out_size, void* d_ws, size_t ws_size, hipStream_t stream) {
    static int grid = 0;
    if (grid == 0) {
        if (n_in != 16 || out_size != S * DM || ws_size < WS_END) { fprintf(stderr, "kernel_launch: unexpected shapes (n_in %d out %d ws %zu)\n", n_in, out_size, ws_size); grid = -1; return; }
        int dev = 0, cus = 0, per_cu = 0;
        hipGetDevice(&dev); hipDeviceGetAttribute(&cus, hipDeviceAttributeMultiprocessorCount, dev);
        if (hipFuncSetAttribute((const void*)fwd, hipFuncAttributeMaxDynamicSharedMemorySize, LDS_BYTES) != hipSuccess) { fprintf(stderr, "kernel_launch: hipFuncSetAttribute failed\n"); grid = -1; return; }
        if (hipOccupancyMaxActiveBlocksPerMultiprocessor(&per_cu, (const void*)fwd, 512, LDS_BYTES) != hipSuccess || per_cu < 1) { fprintf(stderr, "kernel_launch: occupancy query says %d\n", per_cu); per_cu = 1; }
        (void)hipGetLastError();
        grid = cus;
    }
    if (grid < 0) return;
    Args a{};
    for (int i = 0; i < 16; ++i) a.in[i] = (const float*)d_in[i];
    a.out = (float*)d_out; a.ws = (unsigned char*)d_ws;
    if (N_LAUNCH_MODE == 1) {
        (void)hipMemsetAsync((unsigned char*)d_ws + WS_BAR, 0, XCD_BAR_WORDS * 4, stream);
        a.ph_lo = 0; a.ph_hi = 11; void* args[] = {&a};
        hipError_t e = hipLaunchCooperativeKernel((const void*)fwd, dim3(grid), dim3(512), args, LDS_BYTES, stream);
        if (e != hipSuccess) fprintf(stderr, "cooperative launch failed: %s (grid %d)\n", hipGetErrorString(e), grid);
    } else {
        for (int p = 0; p < 11; ++p) { a.ph_lo = p; a.ph_hi = p + 1; hipLaunchKernelGGL(fwd, dim3(grid), dim3(512), LDS_BYTES, stream, a); }
    }
}
```

```cpp
#include <hip/hip_runtime.h>
#include <cstdio>
#include <cstdint>
namespace pg8 {
#define PG8_LAS __attribute__((address_space(3)))
typedef unsigned short bf16_t;
typedef short bf16x8 __attribute__((ext_vector_type(8)));
typedef float f32x4 __attribute__((ext_vector_type(4)));
typedef unsigned u32x4 __attribute__((ext_vector_type(4)));
constexpr int BM = 256, BK = 64, HALF = 128, HTB = HALF * BK * 2  , STAGE_BYTES = 8 * HTB, NXCD = 8, WGM = 8;

__host__ __device__ __forceinline__ int lds_byte(int r, int c) { const int st = (r >> 4) * 2 + (c >> 5), rr = r & 15, cc = c & 31, ob = rr * 64 + cc * 2; return st * 1024 + (ob ^ (((ob >> 9) & 1) << 5)); }
__host__ __device__ __forceinline__ void stage_rc(int b, int& R, int& C) { const int st = b / 1024, sb = b % 1024, swz = sb ^ (((sb >> 9) & 1) << 5); R = (st >> 1) * 16 + swz / 64; C = (st & 1) * 32 + (swz % 64) / 2; }
__host__ __device__ __forceinline__ int perm32(int rho) { const int n = rho >> 4, i = rho & 15; return 8 * (i >> 2) + 4 * n + (i & 3); }

struct Unit { int pm, pn, ty; };
struct Gemm { const bf16_t* A; const bf16_t* Bt; int M, N, K; };

struct StaticOrder {
    int nM, nN, nwg, G, c;
    __host__ __device__ void init(int M, int N, int G_, int c_) { nM = M / BM; nN = N / BM; nwg = nM * nN; G = G_; c = c_; }
    __host__ __device__ bool at(long L, Unit& u) const {
        if (L >= nwg) return false;
        int wgid = (int)L; { const int q = nwg / NXCD, r = nwg % NXCD, xcd = wgid % NXCD, off = wgid / NXCD; wgid = (xcd < r ? xcd * (q + 1) : r * (q + 1) + (xcd - r) * q) + off; }
        const int nig = WGM * nN, gid = wgid / nig, fm = gid * WGM, gsz = (nM - fm) < WGM ? (nM - fm) : WGM;
        u.pm = fm + ((wgid % nig) % gsz); u.pn = (wgid % nig) / gsz; u.ty = 0; return true;
    }
    __host__ __device__ bool next(int i, Unit& u) const { return at((long)i * G + c, u); }
    __device__ __forceinline__ const char* pA(const Unit& u, const Gemm& g, size_t tstep) const { return (const char*)g.A + (size_t)u.pm * tstep; }
    __device__ __forceinline__ const char* pB(const Unit& u, const Gemm& g, size_t tstep) const { return (const char*)g.Bt + (size_t)u.pn * tstep; }
    __device__ __forceinline__ int K(const Unit&, const Gemm& g) const { return g.K; }
    __device__ __forceinline__ void a_ready(const Unit&) const {}
    __device__ __forceinline__ void done(const Unit&) const {}
};
struct DualOrder {
    StaticOrder s0, s1; int G, c; const bf16_t* A1; const bf16_t* B1;
    __host__ __device__ void init(int M0, int N0, int M1, int N1, int G_, int c_, const bf16_t* A1_, const bf16_t* B1_) { s0.init(M0, N0, G_, c_); s1.init(M1, N1, G_, c_); G = G_; c = c_; A1 = A1_; B1 = B1_; }
    __host__ __device__ bool next(int i, Unit& u) const { const long L = (long)i * G + c; if (L < s0.nwg) return s0.at(L, u); const bool ok = s1.at(L - s0.nwg, u); u.ty = 1; return ok; }
    __device__ __forceinline__ const char* pA(const Unit& u, const Gemm& g, size_t tstep) const { return (const char*)(u.ty ? A1 : g.A) + (size_t)u.pm * tstep; }
    __device__ __forceinline__ const char* pB(const Unit& u, const Gemm& g, size_t tstep) const { return (const char*)(u.ty ? B1 : g.Bt) + (size_t)u.pn * tstep; }
    __device__ __forceinline__ int K(const Unit&, const Gemm& g) const { return g.K; }
    __device__ __forceinline__ void a_ready(const Unit&) const {}
    __device__ __forceinline__ void done(const Unit&) const {}
};
struct TriOrder {
    StaticOrder s0, s1, s2; int G, c; const bf16_t *A1, *B1, *A2, *B2; int K1, K2v;
    __host__ __device__ void init(int M0, int N0, int M1, int N1, int M2, int N2, int G_, int c_, const bf16_t* A1_, const bf16_t* B1_, int K1_, const bf16_t* A2_, const bf16_t* B2_, int K2_) {
        s0.init(M0, N0, G_, c_); s1.init(M1, N1, G_, c_); s2.init(M2, N2, G_, c_); G = G_; c = c_; A1 = A1_; B1 = B1_; K1 = K1_; A2 = A2_; B2 = B2_; K2v = K2_; }
    __host__ __device__ bool full(long L, Unit& u) const { if (L < s0.nwg) return s0.at(L, u); const bool ok = s1.at(L - s0.nwg, u); u.ty = 1; return ok; }
    __host__ __device__ bool next(int i, Unit& u) const {
        const int n01 = s0.nwg + s1.nwg, rf = n01 / G, rem = n01 % G;
        if (i < rf) return full((long)i * G + c, u);
        long j;
        if (rem == 0) j = (long)(i - rf) * G + c;
        else { if (c < rem) { if (i == rf) return full((long)i * G + c, u); return false; } j = (long)(i - rf) * (G - rem) + (c - rem); }
        const bool ok = s2.at(j, u); u.ty = 2; return ok;
    }
    __device__ __forceinline__ const char* pA(const Unit& u, const Gemm& g, size_t tstep) const { return (const char*)(u.ty == 0 ? g.A : (u.ty == 1 ? A1 : A2)) + (size_t)u.pm * tstep; }
    __device__ __forceinline__ const char* pB(const Unit& u, const Gemm& g, size_t tstep) const { return (const char*)(u.ty == 0 ? g.Bt : (u.ty == 1 ? B1 : B2)) + (size_t)u.pn * tstep; }
    __device__ __forceinline__ int K(const Unit& u, const Gemm& g) const { return u.ty == 0 ? g.K : (u.ty == 1 ? K1 : K2v); }
    __device__ __forceinline__ void a_ready(const Unit&) const {}
    __device__ __forceinline__ void done(const Unit&) const {}
};
template <class E0, class E1, class E2> struct EpiTri {
    static constexpr bool PERM = true, AFTER_DRAIN = false;
    E0 e0; E1 e1; E2 e2;
    __device__ __forceinline__ void init(f32x4 (&acc)[2][2][4][2], const Unit& u, int wr, int wc, int fr, int fq) const { if (u.ty == 0) e0.init(acc, u, wr, wc, fr, fq); else if (u.ty == 1) e1.init(acc, u, wr, wc, fr, fq); else e2.init(acc, u, wr, wc, fr, fq); }
    __device__ __forceinline__ void operator()(const f32x4 (&acc)[2][2][4][2], const Unit& u, int wr, int wc, int fr, int fq) const { if (u.ty == 0) e0(acc, u, wr, wc, fr, fq); else if (u.ty == 1) e1(acc, u, wr, wc, fr, fq); else e2(acc, u, wr, wc, fr, fq); }
};
template <class E0, class E1> struct EpiDual {
    static constexpr bool PERM = true, AFTER_DRAIN = false;
    E0 e0; E1 e1;
    __device__ __forceinline__ void init(f32x4 (&acc)[2][2][4][2], const Unit& u, int wr, int wc, int fr, int fq) const { if (u.ty == 0) e0.init(acc, u, wr, wc, fr, fq); else e1.init(acc, u, wr, wc, fr, fq); }
    __device__ __forceinline__ void operator()(const f32x4 (&acc)[2][2][4][2], const Unit& u, int wr, int wc, int fr, int fq) const { if (u.ty == 0) e0(acc, u, wr, wc, fr, fq); else e1(acc, u, wr, wc, fr, fq); }
};

__device__ __forceinline__ unsigned cvt_pk_bf16(float lo, float hi) { unsigned r; asm volatile("v_cvt_pk_bf16_f32 %0, %1, %2" : "=v"(r) : "v"(lo), "v"(hi)); return r; }
typedef float f32x2 __attribute__((ext_vector_type(2)));
typedef unsigned u32x2 __attribute__((ext_vector_type(2)));
#define GASQ __attribute__((address_space(1)))
constexpr float QS_MLA = 0.07216878364870322f * 1.4426950408889634f;
constexpr float QS_MB  = 0.08838834764831845f * 1.4426950408889634f;
constexpr float EPSN = 1e-6f;
__device__ __forceinline__ u32x4 pack8(f32x4 a, f32x4 b) { u32x4 w; w.x = cvt_pk_bf16(a[0], a[1]); w.y = cvt_pk_bf16(a[2], a[3]); w.z = cvt_pk_bf16(b[0], b[1]); w.w = cvt_pk_bf16(b[2], b[3]); return w; }
__device__ __forceinline__ float sq4(f32x4 a) { return (a[0] * a[0] + a[1] * a[1]) + (a[2] * a[2] + a[3] * a[3]); }
__device__ __forceinline__ float bf2f(unsigned short h) { return __uint_as_float(((unsigned)h) << 16); }
__device__ __forceinline__ void rope8(const float* tabp, f32x4 a0, f32x4 a1, f32x4 b0, f32x4 b1, f32x4& x0, f32x4& x1, f32x4& y0, f32x4& y1) {
    const f32x4 t0 = *(const f32x4*)tabp, t1 = *(const GASQ f32x4*)(tabp + 4), t2 = *(const GASQ f32x4*)(tabp + 8), t3 = *(const GASQ f32x4*)(tabp + 12);
    x0 = (f32x4){a0[0] * t0[0] - b0[0] * t0[1], a0[1] * t0[2] - b0[1] * t0[3], a0[2] * t1[0] - b0[2] * t1[1], a0[3] * t1[2] - b0[3] * t1[3]};
    x1 = (f32x4){a1[0] * t2[0] - b1[0] * t2[1], a1[1] * t2[2] - b1[1] * t2[3], a1[2] * t3[0] - b1[2] * t3[1], a1[3] * t3[2] - b1[3] * t3[3]};
    y0 = (f32x4){b0[0] * t0[0] + a0[0] * t0[1], b0[1] * t0[2] + a0[1] * t0[3], b0[2] * t1[0] + a0[2] * t1[1], b0[3] * t1[2] + a0[3] * t1[3]};
    y1 = (f32x4){b1[0] * t2[0] + a1[0] * t2[1], b1[1] * t2[2] + a1[1] * t2[3], b1[2] * t3[0] + a1[2] * t3[1], b1[3] * t3[2] + a1[3] * t3[3]};
}
#define EPI_ZERO(acc) _Pragma("unroll") for (int a_ = 0; a_ < 2; ++a_) _Pragma("unroll") for (int b_ = 0; b_ < 2; ++b_) _Pragma("unroll") for (int m_ = 0; m_ < 4; ++m_) _Pragma("unroll") for (int n_ = 0; n_ < 2; ++n_) acc[a_][b_][m_][n_] = (f32x4){0.f, 0.f, 0.f, 0.f}
#define EPI_ROWS_BEGIN _Pragma("unroll") for (int ai = 0; ai < 2; ++ai) _Pragma("unroll") for (int m = 0; m < 4; ++m) { const int row = u.pm * BM + ai * HALF + wr * 64 + m * 16 + fr; \
        const f32x4 a0 = acc[ai][0][m][0], a1 = acc[ai][0][m][1], b0 = acc[ai][1][m][0], b1 = acc[ai][1][m][1];
#define EPI_ROWS_END }
struct EpiProj {
    static constexpr bool PERM = true, AFTER_DRAIN = false;
    __device__ __forceinline__ void init(f32x4 (&acc)[2][2][4][2], const Unit&, int, int, int, int) const { EPI_ZERO(acc); }
    bf16_t *qmla, *kmla, *ckv, *qmb, *kmb; float* ssqc; const float* tab128; const float* tab64;
    __device__ __forceinline__ void operator()(const f32x4 (&acc)[2][2][4][2], const Unit& u, int wr, int wc, int fr, int fq) const {
        asm volatile("" : "+v"(fr), "+v"(fq));
        const int t = u.pn, c8 = wc * 32 + 8 * fq;
        EPI_ROWS_BEGIN
            if (t < 4) {
                *(GASQ u32x4*)(qmla + (size_t)row * 1536 + (2 * t) * 192 + c8) = pack8(a0 * QS_MLA, a1 * QS_MLA);
                *(GASQ u32x4*)(qmla + (size_t)row * 1536 + (2 * t + 1) * 192 + c8) = pack8(b0 * QS_MLA, b1 * QS_MLA);
            } else if (t < 6) {
                const int head = 4 * (t - 4) + (c8 >> 5), i0 = c8 & 31; f32x4 x0, x1, y0, y1;
                rope8(tab64 + ((size_t)row * 32 + i0) * 2, a0, a1, b0, b1, x0, x1, y0, y1);
                *(GASQ u32x4*)(qmla + (size_t)row * 1536 + head * 192 + 128 + i0) = pack8(x0 * QS_MLA, x1 * QS_MLA);
                *(GASQ u32x4*)(qmla + (size_t)row * 1536 + head * 192 + 160 + i0) = pack8(y0 * QS_MLA, y1 * QS_MLA);
            } else if (t < 8) {
                *(GASQ u32x4*)(ckv + (size_t)row * 512 + 256 * (t - 6) + c8) = pack8(a0, a1);
                *(GASQ u32x4*)(ckv + (size_t)row * 512 + 256 * (t - 6) + 128 + c8) = pack8(b0, b1);
                float s = (sq4(a0) + sq4(a1)) + (sq4(b0) + sq4(b1)); s += __shfl_xor(s, 16); s += __shfl_xor(s, 32);
                if (fq == 0) unsafeAtomicAdd(ssqc + row, s);
            } else if (t < 16) {
                const bool isq = t < 12; const int uu = isq ? t - 8 : t - 12; const int head = 2 * uu + (c8 >> 6), i0 = c8 & 63; f32x4 x0, x1, y0, y1;
                rope8(tab128 + ((size_t)row * 64 + i0) * 2, a0, a1, b0, b1, x0, x1, y0, y1);
                bf16_t* dst = (isq ? qmb : kmb) + (size_t)row * 1024 + head * 128 + i0; const float sc = isq ? QS_MB : 1.0f;
                *(GASQ u32x4*)(dst) = pack8(x0 * sc, x1 * sc);
                *(GASQ u32x4*)(dst + 64) = pack8(y0 * sc, y1 * sc);
            } else {
                if (c8 < 32) { f32x4 x0, x1, y0, y1;
                    rope8(tab64 + ((size_t)row * 32 + c8) * 2, a0, a1, b0, b1, x0, x1, y0, y1);
                    const u32x4 w1 = pack8(x0, x1), w2 = pack8(y0, y1);
#pragma unroll
                    for (int h = 0; h < 8; ++h) { *(GASQ u32x4*)(kmla + (size_t)row * 1536 + h * 192 + 128 + c8) = w1; *(GASQ u32x4*)(kmla + (size_t)row * 1536 + h * 192 + 160 + c8) = w2; } }
            }
        EPI_ROWS_END
    }
};
template <bool SCALE> struct EpiT {
    static constexpr bool PERM = true, AFTER_DRAIN = false;
    __device__ __forceinline__ void init(f32x4 (&acc)[2][2][4][2], const Unit&, int, int, int, int) const { EPI_ZERO(acc); }
    bf16_t* O; int ldc; const float* ssq; float invn;
    __device__ __forceinline__ void operator()(const f32x4 (&acc)[2][2][4][2], const Unit& u, int wr, int wc, int fr, int fq) const {
        asm volatile("" : "+v"(fr), "+v"(fq));
        const int c8 = wc * 32 + 8 * fq, colA = u.pn * BM + c8, colB = colA + HALF;
        f32x4 sa0 = (f32x4){1.f, 1.f, 1.f, 1.f}, sa1 = sa0, sb0 = sa0, sb1 = sa0;
        if (SCALE) { sa0 = *(const GASQ f32x4*)(ssq + colA); sa1 = *(const GASQ f32x4*)(ssq + colA + 4); sb0 = *(const GASQ f32x4*)(ssq + colB); sb1 = *(const GASQ f32x4*)(ssq + colB + 4);
#pragma unroll
            for (int j = 0; j < 4; ++j) { sa0[j] = __builtin_amdgcn_rsqf(sa0[j] * invn + EPSN); sa1[j] = __builtin_amdgcn_rsqf(sa1[j] * invn + EPSN); sb0[j] = __builtin_amdgcn_rsqf(sb0[j] * invn + EPSN); sb1[j] = __builtin_amdgcn_rsqf(sb1[j] * invn + EPSN); } }
        EPI_ROWS_BEGIN
            if (SCALE) { *(GASQ u32x4*)(O + (size_t)row * ldc + colA) = pack8(a0 * sa0, a1 * sa1); *(GASQ u32x4*)(O + (size_t)row * ldc + colB) = pack8(b0 * sb0, b1 * sb1); }
            else { *(GASQ u32x4*)(O + (size_t)row * ldc + colA) = pack8(a0, a1); *(GASQ u32x4*)(O + (size_t)row * ldc + colB) = pack8(b0, b1); }
        EPI_ROWS_END
    }
};
struct EpiKnope {
    static constexpr bool PERM = true, AFTER_DRAIN = false;
    __device__ __forceinline__ void init(f32x4 (&acc)[2][2][4][2], const Unit&, int, int, int, int) const { EPI_ZERO(acc); }
    bf16_t* kmla; const float* ssqc;
    __device__ __forceinline__ void operator()(const f32x4 (&acc)[2][2][4][2], const Unit& u, int wr, int wc, int fr, int fq) const {
        asm volatile("" : "+v"(fr), "+v"(fq));
        const int c8 = wc * 32 + 8 * fq;
        EPI_ROWS_BEGIN
            const float r = __builtin_amdgcn_rsqf(ssqc[row] * (1.0f / 512.0f) + EPSN);
            *(GASQ u32x4*)(kmla + (size_t)row * 1536 + (2 * u.pn) * 192 + c8) = pack8(a0 * r, a1 * r);
            *(GASQ u32x4*)(kmla + (size_t)row * 1536 + (2 * u.pn + 1) * 192 + c8) = pack8(b0 * r, b1 * r);
        EPI_ROWS_END
    }
};
__device__ __forceinline__ void unpack8(u32x4 w, f32x4& lo, f32x4& hi) {
    lo = (f32x4){__uint_as_float(w.x << 16), __uint_as_float(w.x & 0xffff0000u), __uint_as_float(w.y << 16), __uint_as_float(w.y & 0xffff0000u)};
    hi = (f32x4){__uint_as_float(w.z << 16), __uint_as_float(w.z & 0xffff0000u), __uint_as_float(w.w << 16), __uint_as_float(w.w & 0xffff0000u)}; }
template <bool BASEF32> struct EpiRes {
    static constexpr bool PERM = true, AFTER_DRAIN = false;
    const void* base; bf16_t* hb; float* ssq;
    __device__ __forceinline__ void init(f32x4 (&acc)[2][2][4][2], const Unit& u, int wr, int wc, int fr, int fq) const {
        asm volatile("" : "+v"(fr), "+v"(fq));
        const int colA = u.pn * BM + wc * 32 + 8 * fq, colB = colA + HALF;
#pragma unroll
        for (int ai = 0; ai < 2; ++ai)
#pragma unroll
            for (int m = 0; m < 4; ++m) { const size_t o = (size_t)(u.pm * BM + ai * HALF + wr * 64 + m * 16 + fr) * 2048;
                if (BASEF32) { const float* bp = (const float*)base; acc[ai][0][m][0] = *(const GASQ f32x4*)(bp + o + colA); acc[ai][0][m][1] = *(const GASQ f32x4*)(bp + o + colA + 4); acc[ai][1][m][0] = *(const GASQ f32x4*)(bp + o + colB); acc[ai][1][m][1] = *(const GASQ f32x4*)(bp + o + colB + 4); }
                else { const bf16_t* bp = (const bf16_t*)base; unpack8(*(const GASQ u32x4*)(bp + o + colA), acc[ai][0][m][0], acc[ai][0][m][1]); unpack8(*(const GASQ u32x4*)(bp + o + colB), acc[ai][1][m][0], acc[ai][1][m][1]); } }
    }
    __device__ __forceinline__ void operator()(const f32x4 (&acc)[2][2][4][2], const Unit& u, int wr, int wc, int fr, int fq) const {
        asm volatile("" : "+v"(fr), "+v"(fq));
        const int colA = u.pn * BM + wc * 32 + 8 * fq, colB = colA + HALF;
        EPI_ROWS_BEGIN
            const size_t o = (size_t)row * 2048;
            *(GASQ u32x4*)(hb + o + colA) = pack8(a0, a1); *(GASQ u32x4*)(hb + o + colB) = pack8(b0, b1);
            float s = (sq4(a0) + sq4(a1)) + (sq4(b0) + sq4(b1)); s += __shfl_xor(s, 16); s += __shfl_xor(s, 32);
            if (fq == 0) unsafeAtomicAdd(ssq + row, s);
        EPI_ROWS_END
    }
};
struct EpiSwiglu {
    static constexpr bool PERM = true, AFTER_DRAIN = false;
    __device__ __forceinline__ void init(f32x4 (&acc)[2][2][4][2], const Unit&, int, int, int, int) const { EPI_ZERO(acc); }
    bf16_t* ff; const float* ssq;
    __device__ __forceinline__ void operator()(const f32x4 (&acc)[2][2][4][2], const Unit& u, int wr, int wc, int fr, int fq) const {
        asm volatile("" : "+v"(fr), "+v"(fq));
        const int c8 = wc * 32 + 8 * fq;
        EPI_ROWS_BEGIN
            const float r = __builtin_amdgcn_rsqf(ssq[row] * (1.0f / 2048.0f) + EPSN);
            f32x4 g0 = a0 * r, g1 = a1 * r; const f32x4 u0 = b0 * r, u1 = b1 * r;
#pragma unroll
            for (int j = 0; j < 4; ++j) { g0[j] = g0[j] * __builtin_amdgcn_rcpf(1.0f + __builtin_amdgcn_exp2f(-1.4426950408889634f * g0[j])) * u0[j]; g1[j] = g1[j] * __builtin_amdgcn_rcpf(1.0f + __builtin_amdgcn_exp2f(-1.4426950408889634f * g1[j])) * u1[j]; }
            *(GASQ u32x4*)(ff + (size_t)row * 5632 + u.pn * 128 + c8) = pack8(g0, g1);
        EPI_ROWS_END
    }
};
__device__ __forceinline__ size_t p_off(int row) { return (size_t)(row >> 8) * 1048576 + (size_t)(row & 255) * 2048; }
struct EpiP {
    static constexpr bool PERM = true, AFTER_DRAIN = false;
    bf16_t* P;
    __device__ __forceinline__ void init(f32x4 (&acc)[2][2][4][2], const Unit&, int, int, int, int) const { EPI_ZERO(acc); }
    __device__ __forceinline__ void operator()(const f32x4 (&acc)[2][2][4][2], const Unit& u, int wr, int wc, int fr, int fq) const {
        asm volatile("" : "+v"(fr), "+v"(fq));
        const int colA = u.pn * BM + wc * 32 + 8 * fq, colB = colA + HALF;
        EPI_ROWS_BEGIN
            const size_t o = p_off(row);
            *(GASQ u32x4*)(P + o + colA) = pack8(a0, a1); *(GASQ u32x4*)(P + o + colB) = pack8(b0, b1);
        EPI_ROWS_END
    }
};
struct EpiPle {
    static constexpr bool PERM = true, AFTER_DRAIN = false;
    __device__ __forceinline__ void init(f32x4 (&acc)[2][2][4][2], const Unit&, int, int, int, int) const { EPI_ZERO(acc); }
    const bf16_t* hb; bf16_t* h3b; const bf16_t* P; const float* ssq2; float* ssq3;
    __device__ __forceinline__ void operator()(const f32x4 (&acc)[2][2][4][2], const Unit& u, int wr, int wc, int fr, int fq) const {
        asm volatile("" : "+v"(fr), "+v"(fq));
        const int colA = u.pn * BM + wc * 32 + 8 * fq, colB = colA + HALF;
        EPI_ROWS_BEGIN
            const size_t o = (size_t)row * 2048; const float r = __builtin_amdgcn_rsqf(ssq2[row] * (1.0f / 2048.0f) + EPSN);
            f32x4 h0, h1, h2, h3, p0, p1, p2, p3;
            unpack8(*(const GASQ u32x4*)(hb + o + colA), h0, h1); unpack8(*(const GASQ u32x4*)(hb + o + colB), h2, h3);
            { const size_t op = p_off(row); unpack8(*(const GASQ u32x4*)(P + op + colA), p0, p1); unpack8(*(const GASQ u32x4*)(P + op + colB), p2, p3); }
#define SIG(x) __builtin_amdgcn_rcpf(1.0f + __builtin_amdgcn_exp2f(-1.4426950408889634f * r * (x)))
#pragma unroll
            for (int j = 0; j < 4; ++j) { h0[j] += SIG(a0[j]) * p0[j]; h1[j] += SIG(a1[j]) * p1[j]; h2[j] += SIG(b0[j]) * p2[j]; h3[j] += SIG(b1[j]) * p3[j]; }
#undef SIG
            *(GASQ u32x4*)(h3b + o + colA) = pack8(h0, h1); *(GASQ u32x4*)(h3b + o + colB) = pack8(h2, h3);
            float s = (sq4(h0) + sq4(h1)) + (sq4(h2) + sq4(h3)); s += __shfl_xor(s, 16); s += __shfl_xor(s, 32);
            if (fq == 0) unsafeAtomicAdd(ssq3 + row, s);
        EPI_ROWS_END
    }
};

struct PanelOrder {
    int c;
    __device__ __forceinline__ bool next(int i, Unit& u) const { if (i >= 2) return false; const int v = (c & 7) * 32 + (c >> 3); u.pm = 32 * i + (v >> 3); u.pn = v & 7; u.ty = 0; return true; }
    __device__ __forceinline__ const char* pA(const Unit& u, const Gemm& g, size_t tstep) const { return (const char*)g.A + (size_t)u.pm * tstep; }
    __device__ __forceinline__ const char* pB(const Unit& u, const Gemm& g, size_t tstep) const { return (const char*)g.Bt + (size_t)u.pn * tstep; }
    __device__ __forceinline__ int K(const Unit&, const Gemm& g) const { return g.K; }
    __device__ __forceinline__ void a_ready(const Unit&) const {}
    __device__ __forceinline__ void done(const Unit&) const {}
};
struct EpiPleFused {
    static constexpr bool PERM = true, AFTER_DRAIN = false;
    const bf16_t* hb; const bf16_t* P; const float* ssq2; float* ssq3; unsigned* pcnt; float* out; const float* gfin;
    __device__ __forceinline__ void init(f32x4 (&acc)[2][2][4][2], const Unit&, int, int, int, int) const { EPI_ZERO(acc); }
    __device__ __forceinline__ void operator()(f32x4 (&acc)[2][2][4][2], const Unit& u, int wr, int wc, int fr, int fq) const {
        asm volatile("" : "+v"(fr), "+v"(fq));
        const int colA = u.pn * BM + wc * 32 + 8 * fq, colB = colA + HALF;
#pragma unroll
        for (int ai = 0; ai < 2; ++ai)
#pragma unroll
            for (int m = 0; m < 4; ++m) { const int row = u.pm * BM + ai * HALF + wr * 64 + m * 16 + fr;
                const size_t o = (size_t)row * 2048, op = p_off(row); const float r = __builtin_amdgcn_rsqf(ssq2[row] * (1.0f / 2048.0f) + EPSN);
                f32x4 h0, h1, h2, h3, p0, p1, p2, p3;
                unpack8(*(const GASQ u32x4*)(hb + o + colA), h0, h1); unpack8(*(const GASQ u32x4*)(hb + o + colB), h2, h3);
                unpack8(*(const GASQ u32x4*)(P + op + colA), p0, p1); unpack8(*(const GASQ u32x4*)(P + op + colB), p2, p3);
#define SIG(x) __builtin_amdgcn_rcpf(1.0f + __builtin_amdgcn_exp2f(-1.4426950408889634f * r * (x)))
#pragma unroll
                for (int j = 0; j < 4; ++j) { h0[j] += SIG(acc[ai][0][m][0][j]) * p0[j]; h1[j] += SIG(acc[ai][0][m][1][j]) * p1[j]; h2[j] += SIG(acc[ai][1][m][0][j]) * p2[j]; h3[j] += SIG(acc[ai][1][m][1][j]) * p3[j]; }
#undef SIG
                acc[ai][0][m][0] = h0; acc[ai][0][m][1] = h1; acc[ai][1][m][0] = h2; acc[ai][1][m][1] = h3;
                float s = (sq4(h0) + sq4(h1)) + (sq4(h2) + sq4(h3)); s += __shfl_xor(s, 16); s += __shfl_xor(s, 32);
                if (fq == 0) unsafeAtomicAdd(ssq3 + row, s); }
        asm volatile("s_waitcnt vmcnt(0)" ::: "memory");
        unsigned* pc = pcnt + 64 * u.pm;
        if (fr == 0 && fq == 0) __hip_atomic_fetch_add(pc, 1u, __ATOMIC_RELAXED, __HIP_MEMORY_SCOPE_AGENT);
        { unsigned sp = 0; while ((unsigned)__builtin_amdgcn_readfirstlane((int)__hip_atomic_load(pc, __ATOMIC_RELAXED, __HIP_MEMORY_SCOPE_AGENT)) < 64u) { __builtin_amdgcn_s_sleep(2); if (++sp > (1u << 22)) break; } }
        asm volatile("" ::: "memory");
        const f32x4 gA0 = *(const GASQ f32x4*)(gfin + colA), gA1 = *(const GASQ f32x4*)(gfin + colA + 4), gB0 = *(const GASQ f32x4*)(gfin + colB), gB1 = *(const GASQ f32x4*)(gfin + colB + 4);
#pragma unroll
        for (int ai = 0; ai < 2; ++ai)
#pragma unroll
            for (int m = 0; m < 4; ++m) { const int row = u.pm * BM + ai * HALF + wr * 64 + m * 16 + fr; const size_t o = (size_t)row * 2048;
                const float s = __uint_as_float(__hip_atomic_load((unsigned*)(ssq3 + row), __ATOMIC_RELAXED, __HIP_MEMORY_SCOPE_AGENT));
                const float r = __builtin_amdgcn_rsqf(s * (1.0f / 2048.0f) + EPSN);
                *(GASQ f32x4*)(out + o + colA) = acc[ai][0][m][0] * r * gA0; *(GASQ f32x4*)(out + o + colA + 4) = acc[ai][0][m][1] * r * gA1;
                *(GASQ f32x4*)(out + o + colB) = acc[ai][1][m][0] * r * gB0; *(GASQ f32x4*)(out + o + colB + 4) = acc[ai][1][m][1] * r * gB1; }
    }
};
struct EpiNone {
    static constexpr bool PERM = true, AFTER_DRAIN = false;
    float* dummy;
    __device__ __forceinline__ void init(f32x4 (&acc)[2][2][4][2], const Unit&, int, int, int, int) const { EPI_ZERO(acc); }
    __device__ __forceinline__ void operator()(const f32x4 (&acc)[2][2][4][2], const Unit& u, int wr, int wc, int fr, int fq) const {
        float s = 0.f;
        EPI_ROWS_BEGIN
            s += (sq4(a0) + sq4(a1)) + (sq4(b0) + sq4(b1));
        EPI_ROWS_END
        if (s == 12345.678f) dummy[0] = s;
    }
};
template <class Epi, class Sched, bool ALIGN_EPI = false, bool SP2 = false>
__device__ __forceinline__ void gemm_phase(PG8_LAS unsigned char* lds, const Gemm g, const Sched& S, const Epi& E) {
    const int tid = threadIdx.x, wid = __builtin_amdgcn_readfirstlane(tid >> 6), lane = tid & 63, wr = wid >> 2, wc = wid & 3, fr = lane & 15, fq = lane >> 4;
    unsigned RA[2], RB[2], C2[2];
#pragma unroll
    for (int i = 0; i < 2; ++i) { int R, C; stage_rc(tid * 16 + i * 8192, R, C); const int Rb = Epi::PERM ? ((R & ~31) + perm32(R & 31)) : R;
        RA[i] = (unsigned)R; RB[i] = (unsigned)Rb; C2[i] = (unsigned)C * 2u; }
    const size_t kstep = (size_t)(BK * 2);
    const unsigned ldsw = (unsigned)wid * 1024u;
    const int aoff = lds_byte(wr * 64 + fr, fq * 8), boff = lds_byte(wc * 32 + fr, fq * 8);
#define PG8_SA(b, h) (((b) * 2 + (h)) * HTB)
#define PG8_SB(b, h) ((4 + (b) * 2 + (h)) * HTB)
#define PG8_STAGE(bufoff, gbase, Rr, K2_) do { _Pragma("unroll") for (int _i = 0; _i < 2; ++_i) \
        __builtin_amdgcn_global_load_lds((const unsigned*)((const char*)(gbase) + ((Rr)[_i] * (unsigned)(K2_) + C2[_i])), (PG8_LAS unsigned*)(lds + (bufoff) + ldsw + _i * 8192), 16, 0, 0); } while (0)
#define PG8_LDA(dst, b, h) do { _Pragma("unroll") for (int m = 0; m < 4; ++m) _Pragma("unroll") for (int k = 0; k < 2; ++k) dst[m][k] = *(const PG8_LAS bf16x8*)(lds + PG8_SA(b, h) + aoff + m * 2048 + k * 1024); } while (0)
#define PG8_LDB(dst, b, h) do { _Pragma("unroll") for (int n = 0; n < 2; ++n) _Pragma("unroll") for (int k = 0; k < 2; ++k) dst[n][k] = *(const PG8_LAS bf16x8*)(lds + PG8_SB(b, h) + boff + n * 2048 + k * 1024); } while (0)
#define PG8_MMA(ai, bj, At, Bt) do { __builtin_amdgcn_s_setprio(1); _Pragma("unroll") for (int m = 0; m < 4; ++m) _Pragma("unroll") for (int n = 0; n < 2; ++n) _Pragma("unroll") for (int k = 0; k < 2; ++k) \
        acc[ai][bj][m][n] = __builtin_amdgcn_mfma_f32_16x16x32_bf16(Bt[n][k], At[m][k], acc[ai][bj][m][n], 0, 0, 0); __builtin_amdgcn_s_setprio(0); } while (0)
#define PG8_WAIT_V(n) asm volatile("s_waitcnt vmcnt(" #n ")" ::: "memory")
#define PG8_WAIT_L(n) asm volatile("s_waitcnt lgkmcnt(" #n ")" ::: "memory")
#define PG8_BAR __builtin_amdgcn_s_barrier()
#define PG8_SCHED __builtin_amdgcn_sched_barrier(0)
    Unit cur, nxt; int ui = 0;
    if (!S.next(0, cur)) return;
    f32x4 acc[2][2][4][2];
    E.init(acc, cur, wr, wc, fr, fq);
    bf16x8 At[4][2], B0[2][2], B1[2][2];
    int K2c = 2 * S.K(cur, g), ntc = K2c / (2 * BK); size_t hstepc = (size_t)HALF * K2c;
    const char* cA = S.pA(cur, g, 2 * hstepc); const char* cB = S.pB(cur, g, 2 * hstepc);
    S.a_ready(cur);
    if constexpr (SP2) {
        PG8_STAGE(PG8_SB(0, 0), cB, RB, K2c); PG8_STAGE(PG8_SB(0, 1), cB + hstepc, RB, K2c); PG8_STAGE(PG8_SA(0, 0), cA, RA, K2c); PG8_STAGE(PG8_SA(0, 1), cA + hstepc, RA, K2c);
        if (wr == 1) PG8_BAR;
        PG8_WAIT_V(2); PG8_BAR;
        PG8_STAGE(PG8_SB(1, 0), cB + kstep, RB, K2c); PG8_STAGE(PG8_SA(1, 0), cA + kstep, RA, K2c); PG8_STAGE(PG8_SB(1, 1), cB + hstepc + kstep, RB, K2c);
        PG8_WAIT_V(6); PG8_BAR;
    } else {
        PG8_STAGE(PG8_SB(0, 0), cB, RB, K2c); PG8_STAGE(PG8_SA(0, 0), cA, RA, K2c); PG8_STAGE(PG8_SB(0, 1), cB + hstepc, RB, K2c); PG8_STAGE(PG8_SA(0, 1), cA + hstepc, RA, K2c);
        if (wr == 1) PG8_BAR;
        PG8_WAIT_V(4); PG8_BAR;
        PG8_STAGE(PG8_SB(1, 0), cB + kstep, RB, K2c); PG8_STAGE(PG8_SA(1, 0), cA + kstep, RA, K2c); PG8_STAGE(PG8_SB(1, 1), cB + hstepc + kstep, RB, K2c);
        PG8_WAIT_V(6); PG8_BAR;
    }
    for (;;) {
        const bool has_next = S.next(ui + 1, nxt);
        const int K2n = has_next ? 2 * S.K(nxt, g) : K2c; const size_t hstepn = (size_t)HALF * K2n;
        const char* nA = has_next ? S.pA(nxt, g, 2 * hstepn) : cA; const char* nB = has_next ? S.pB(nxt, g, 2 * hstepn) : cB;
        for (int t = 0; t < ntc; t += 2) {
            const bool last = (t == ntc - 2);
            const int K2x = last ? K2n : K2c; const size_t hstepx = last ? hstepn : hstepc;
            const char* a1 = cA + (size_t)(t + 1) * kstep;
            const char* a2 = last ? nA : cA + (size_t)(t + 2) * kstep; const char* b2 = last ? nB : cB + (size_t)(t + 2) * kstep;
            const char* a3 = a2 + kstep; const char* b3 = b2 + kstep;
            if (last && has_next) S.a_ready(nxt);
            if constexpr (SP2) {
            PG8_LDB(B0, 0, 0); PG8_LDB(B1, 0, 1); PG8_SCHED; PG8_LDA(At, 0, 0); PG8_STAGE(PG8_SA(1, 1), a1 + hstepc, RA, K2c);
            PG8_WAIT_V(8); PG8_WAIT_L(0); PG8_BAR; PG8_MMA(0, 0, At, B0); PG8_MMA(0, 1, At, B1); PG8_BAR; PG8_SCHED;
            PG8_LDA(At, 0, 1); PG8_STAGE(PG8_SB(0, 0), b2, RB, K2x); PG8_STAGE(PG8_SB(0, 1), b2 + hstepx, RB, K2x); PG8_STAGE(PG8_SA(0, 0), a2, RA, K2x);
            PG8_WAIT_V(8); PG8_WAIT_L(0); PG8_BAR; PG8_MMA(1, 0, At, B0); PG8_MMA(1, 1, At, B1); PG8_BAR; PG8_SCHED;
            PG8_LDB(B0, 1, 0); PG8_LDB(B1, 1, 1); PG8_SCHED; PG8_LDA(At, 1, 0); PG8_STAGE(PG8_SA(0, 1), a2 + hstepx, RA, K2x);
            PG8_WAIT_V(8); PG8_WAIT_L(0); PG8_BAR; PG8_MMA(0, 0, At, B0); PG8_MMA(0, 1, At, B1); PG8_BAR; PG8_SCHED;
            PG8_LDA(At, 1, 1); PG8_STAGE(PG8_SB(1, 0), b3, RB, K2x); PG8_STAGE(PG8_SB(1, 1), b3 + hstepx, RB, K2x); PG8_STAGE(PG8_SA(1, 0), a3, RA, K2x);
            PG8_WAIT_V(8); PG8_WAIT_L(0); PG8_BAR; PG8_MMA(1, 0, At, B0); PG8_MMA(1, 1, At, B1); PG8_BAR; PG8_SCHED;
            } else {
            PG8_LDB(B0, 0, 0); PG8_SCHED; PG8_LDA(At, 0, 0); PG8_STAGE(PG8_SA(1, 1), a1 + hstepc, RA, K2c);
            PG8_WAIT_L(8); PG8_BAR; PG8_WAIT_L(0); PG8_MMA(0, 0, At, B0); PG8_BAR; PG8_SCHED;
            PG8_LDB(B1, 0, 1); PG8_STAGE(PG8_SB(0, 0), b2, RB, K2x);
            PG8_BAR; PG8_WAIT_L(0); PG8_MMA(0, 1, At, B1); PG8_BAR;
            PG8_LDA(At, 0, 1); PG8_STAGE(PG8_SA(0, 0), a2, RA, K2x);
            PG8_BAR; PG8_WAIT_L(0); PG8_MMA(1, 0, At, B0); PG8_BAR; PG8_SCHED;
            PG8_STAGE(PG8_SB(0, 1), b2 + hstepx, RB, K2x);
            PG8_WAIT_V(6); PG8_BAR; PG8_MMA(1, 1, At, B1); PG8_BAR;
            PG8_LDB(B0, 1, 0); PG8_SCHED; PG8_LDA(At, 1, 0); PG8_STAGE(PG8_SA(0, 1), a2 + hstepx, RA, K2x);
            PG8_WAIT_L(8); PG8_BAR; PG8_WAIT_L(0); PG8_MMA(0, 0, At, B0); PG8_BAR; PG8_SCHED;
            PG8_LDB(B1, 1, 1); PG8_STAGE(PG8_SB(1, 0), b3, RB, K2x);
            PG8_BAR; PG8_WAIT_L(0); PG8_MMA(0, 1, At, B1); PG8_BAR;
            PG8_LDA(At, 1, 1); PG8_STAGE(PG8_SA(1, 0), a3, RA, K2x);
            PG8_BAR; PG8_WAIT_L(0); PG8_MMA(1, 0, At, B0); PG8_BAR; PG8_SCHED;
            PG8_STAGE(PG8_SB(1, 1), b3 + hstepx, RB, K2x);
            PG8_WAIT_V(6); PG8_BAR; PG8_MMA(1, 1, At, B1); PG8_BAR;
            }
        }
        if constexpr (ALIGN_EPI) { if (wr == 0) PG8_BAR; }
        if constexpr (!Epi::AFTER_DRAIN) { E(acc, cur, wr, wc, fr, fq); S.done(cur); }
        if (!has_next) break;
        E.init(acc, nxt, wr, wc, fr, fq);
        cur = nxt; cA = nA; cB = nB; K2c = K2n; hstepc = hstepn; ntc = K2c / (2 * BK); ++ui;
        if constexpr (ALIGN_EPI) { if (wr == 1) PG8_BAR; }
    }
    PG8_WAIT_V(0);
    if constexpr (!ALIGN_EPI) { if (wr == 0) PG8_BAR; }
    PG8_BAR;
    if constexpr (Epi::AFTER_DRAIN) { E.fused(acc, cur, wr, wc, fr, fq, lds, wid, lane); S.done(cur); }
#undef PG8_SA
#undef PG8_SB
#undef PG8_STAGE
#undef PG8_LDA
#undef PG8_LDB
#undef PG8_MMA
#undef PG8_WAIT_V
#undef PG8_WAIT_L
#undef PG8_BAR
#undef PG8_SCHED
}
}
namespace att {
#define ALAS __attribute__((address_space(3)))
#define AGAS __attribute__((address_space(1)))
typedef unsigned short bf16_t;
typedef short bf16x8 __attribute__((ext_vector_type(8)));
typedef float f32x16 __attribute__((ext_vector_type(16)));
typedef unsigned u32x4 __attribute__((ext_vector_type(4)));
typedef unsigned u32x2 __attribute__((ext_vector_type(2)));
typedef float f32x2_t __attribute__((ext_vector_type(2))); typedef __bf16 bf16x2_t __attribute__((ext_vector_type(2)));
constexpr int SEQ = 16384;
constexpr int VROW = 144, KBYTES = 64 * 400, VBYTES = 128 * VROW;
constexpr int VBASE = 2 * KBYTES, ATT_LDS = 2 * KBYTES + 3 * VBYTES;
__device__ __forceinline__ unsigned cvtpk(float lo, float hi) { f32x2_t v = {lo, hi}; bf16x2_t b = __builtin_convertvector(v, bf16x2_t); return __builtin_bit_cast(unsigned, b); }
__device__ __forceinline__ int crow(int r, int hi) { return (r & 3) + 8 * (r >> 2) + 4 * hi; }


#define ASB() __builtin_amdgcn_sched_barrier(0)
#define DSR128(dst, addr, off) asm volatile("ds_read_b128 %0, %1 offset:%2" : "=v"(dst) : "v"(addr), "i"(off))
#define LGKM_WAIT2(n, x, y) do { if ((n) >= 4) asm volatile("s_waitcnt lgkmcnt(4)" : "+v"(x), "+v"(y)); else if ((n) == 2) asm volatile("s_waitcnt lgkmcnt(2)" : "+v"(x), "+v"(y)); else asm volatile("s_waitcnt lgkmcnt(0)" : "+v"(x), "+v"(y)); } while (0)
#define LGKM_WAIT1(n, x) do { if ((n) >= 3) asm volatile("s_waitcnt lgkmcnt(3)" : "+v"(x)); else if ((n) == 2) asm volatile("s_waitcnt lgkmcnt(2)" : "+v"(x)); else if ((n) == 1) asm volatile("s_waitcnt lgkmcnt(1)" : "+v"(x)); else asm volatile("s_waitcnt lgkmcnt(0)" : "+v"(x)); } while (0)
template <int DQK, bool NOLDS = false> __device__ __forceinline__ void qk_tile(const ALAS unsigned char* kb, const bf16x8 (&qr)[DQK / 16], f32x16& p0, f32x16& p1) {
    constexpr int KROW = DQK * 2 + 16, ND = DQK / 16;
    const unsigned kaddr = (unsigned)(size_t)kb;
    bf16x8 fa[3], fb[3];
    asm volatile("s_waitcnt lgkmcnt(0)" ::: "memory");
    DSR128(fa[0], kaddr, 0); DSR128(fb[0], kaddr, 32 * KROW);
    DSR128(fa[1], kaddr, 32); DSR128(fb[1], kaddr, 32 * KROW + 32);
    DSR128(fa[2], kaddr, 64); DSR128(fb[2], kaddr, 32 * KROW + 64);
    __builtin_amdgcn_s_setprio(1);
#pragma unroll
    for (int d0 = 0; d0 < ND; ++d0) {
        const int sl = d0 % 3, rem = ND - 1 - d0;
        if (NOLDS) { if (d0 == 0) LGKM_WAIT2(0, fa[sl], fb[sl]); } else LGKM_WAIT2(rem >= 2 ? 4 : 2 * rem, fa[sl], fb[sl]);
        p0 = __builtin_amdgcn_mfma_f32_32x32x16_bf16(fa[sl], qr[d0], p0, 0, 0, 0); p1 = __builtin_amdgcn_mfma_f32_32x32x16_bf16(fb[sl], qr[d0], p1, 0, 0, 0);
        if (!NOLDS && d0 + 3 < ND) { DSR128(fa[sl], kaddr, (d0 + 3) * 32); DSR128(fb[sl], kaddr, 32 * KROW + (d0 + 3) * 32); }
    }
    __builtin_amdgcn_s_setprio(0);
}
template <bool NOLDS = false> __device__ __forceinline__ void pv_tile(const ALAS unsigned char* vb, const bf16x8 (&pf)[4], f32x16 (&o)[4]) {
    const unsigned vaddr = (unsigned)(size_t)vb;
    bf16x8 vf[4];
    asm volatile("s_waitcnt lgkmcnt(0)" ::: "memory");
    DSR128(vf[0], vaddr, 0); DSR128(vf[1], vaddr, 32); DSR128(vf[2], vaddr, 64); DSR128(vf[3], vaddr, 96);
    __builtin_amdgcn_s_setprio(1);
#pragma unroll
    for (int j = 0; j < 16; ++j) {
        const int sl = j & 3, rem = 15 - j;
        if (NOLDS) { if (j == 0) LGKM_WAIT1(0, vf[sl]); } else if ((j & 1) == 0) LGKM_WAIT2(rem >= 3 ? 2 : 0, vf[sl], vf[sl + 1]);
        o[j >> 2] = __builtin_amdgcn_mfma_f32_32x32x16_bf16(vf[sl], pf[sl], o[j >> 2], 0, 0, 0);
        if (!NOLDS && j + 4 < 16) DSR128(vf[sl], vaddr, ((j + 4) >> 2) * 32 * VROW + ((j + 4) & 3) * 32);
    }
    __builtin_amdgcn_s_setprio(0);
}

__device__ __forceinline__ void gate_unit(ALAS unsigned char* lds, const bf16_t* Qh, const bf16_t* kmean_h, int qb, unsigned* cnt_h, unsigned* list_h) {
    constexpr int KROW = 272;
    if (qb == 0) return;
    int tid = threadIdx.x; asm volatile("" : "+v"(tid));
    const int lane = tid & 63, r32 = lane & 31, hi = lane >> 5, wid = __builtin_amdgcn_readfirstlane(tid >> 6);
    const int q = qb * 256 + wid * 32 + r32;
    bf16x8 qr[8];
    { const bf16_t* qp = Qh + (size_t)q * 1024 + 8 * hi;
#pragma unroll
      for (int d0 = 0; d0 < 8; ++d0) qr[d0] = *(const AGAS bf16x8*)(qp + 16 * d0); }
#pragma unroll
    for (int j = 0; j < 2; ++j) { const int idx = tid + 512 * j, row = idx >> 4, ch = idx & 15;
        *(ALAS u32x4*)(lds + row * KROW + ch * 16) = *(const AGAS u32x4*)(kmean_h + row * 128 + ch * 8); }
    __syncthreads();
    f32x16 p0, p1;
#pragma unroll
    for (int r = 0; r < 16; ++r) { p0[r] = 0.f; p1[r] = 0.f; }
    qk_tile<128>(lds + r32 * KROW + hi * 16, qr, p0, p1);
    float v1 = -3e38f, v2 = -3e38f, v3 = -3e38f; int i1 = -1, i2 = -1, i3 = -1;
#define TOP_INS(xv_, xn_) do { const float xv = (xv_); const int xn = (xn_); const bool g1 = xv > v1, g2 = xv > v2, g3 = xv > v3; \
        v3 = g2 ? v2 : (g3 ? xv : v3); i3 = g2 ? i2 : (g3 ? xn : i3); v2 = g1 ? v1 : (g2 ? xv : v2); i2 = g1 ? i1 : (g2 ? xn : i2); v1 = g1 ? xv : v1; i1 = g1 ? xn : i1; } while (0)
#pragma unroll
    for (int r = 0; r < 16; ++r) { const int n = crow(r, hi); TOP_INS(n < qb ? p0[r] : -3e38f, n); }
#pragma unroll
    for (int r = 0; r < 16; ++r) { const int n = 32 + crow(r, hi); TOP_INS(n < qb ? p1[r] : -3e38f, n); }
    { const float w1 = __shfl_xor(v1, 32), w2 = __shfl_xor(v2, 32), w3 = __shfl_xor(v3, 32); const int j1 = __shfl_xor(i1, 32), j2 = __shfl_xor(i2, 32), j3 = __shfl_xor(i3, 32);
      TOP_INS(w1, j1); TOP_INS(w2, j2); TOP_INS(w3, j3); }
#undef TOP_INS
    if (hi == 0) {
        if (i1 >= 0) { const unsigned pos = atomicAdd(cnt_h + i1, 1u); list_h[(size_t)i1 * SEQ + pos] = ((unsigned)q << 2) | 0u; }
        if (i2 >= 0) { const unsigned pos = atomicAdd(cnt_h + i2, 1u); list_h[(size_t)i2 * SEQ + pos] = ((unsigned)q << 2) | 1u; }
        if (i3 >= 0) { const unsigned pos = atomicAdd(cnt_h + i3, 1u); list_h[(size_t)i3 * SEQ + pos] = ((unsigned)q << 2) | 2u; }
    }
    __syncthreads();
}

template <int DQK, int MODE, int PROBE = 0>
__device__ __forceinline__ void unit(ALAS unsigned char* lds, const bf16_t* Q, int ldq, const bf16_t* K, int ldk, const bf16_t* VT, bf16_t* O, int qb,
                                     const unsigned* lst, int nvalid, bf16_t* part, float* ml, int h) {
    constexpr int KROW = DQK * 2 + 16, ND = DQK / 16, KCH = DQK / 8, KPT = 64 * KCH / 512;
    int tid = threadIdx.x; asm volatile("" : "+v"(tid));
    const int lane = tid & 63, r32 = lane & 31, hi = lane >> 5, wid = __builtin_amdgcn_readfirstlane(tid >> 6);
    const int q0 = qb * 256, qrel = wid * 32 + r32;
    const int T0 = MODE == 0 ? 0 : 4 * qb, NT = MODE == 0 ? 4 * qb + 4 : 4;
    u32x4 kst[KPT], vst[2];
    const int srow = tid >> 3, sc = tid & 7;
    unsigned kgo = (unsigned)(srow * ldk + 8 * sc), klo = (unsigned)(srow * KROW + 16 * sc);
    unsigned vgo = (unsigned)(srow * SEQ + 8 * sc), vlo = (unsigned)(srow * VROW + 32 * (sc >> 1) + 8 * (sc & 1));
#define ATT_LOAD(t) do { asm volatile("" : "+v"(kgo), "+v"(vgo)); const bf16_t* kt_ = K + (size_t)(64 * (T0 + (t))) * ldk; const bf16_t* vt_ = VT + 64 * (T0 + (t)); \
        _Pragma("unroll") for (int j = 0; j < KPT; ++j) kst[j] = *(const AGAS u32x4*)(kt_ + kgo + 64 * j); \
        vst[0] = *(const AGAS u32x4*)(vt_ + vgo); vst[1] = *(const AGAS u32x4*)(vt_ + (size_t)64 * SEQ + vgo); } while (0)
#define ATT_STORE(kb, vb) do { asm volatile("" : "+v"(klo), "+v"(vlo)); ALAS unsigned char* kb_ = lds + (kb) * KBYTES; ALAS unsigned char* vb_ = lds + VBASE + (vb) * VBYTES; \
        _Pragma("unroll") for (int j = 0; j < KPT; ++j) *(ALAS u32x4*)(kb_ + klo + 128 * j) = kst[j]; \
        _Pragma("unroll") for (int j = 0; j < 2; ++j) { ALAS unsigned char* vp = vb_ + vlo + j * 64 * VROW; \
            *(ALAS u32x2*)(vp) = (u32x2){vst[j].x, vst[j].y}; *(ALAS u32x2*)(vp + 16) = (u32x2){vst[j].z, vst[j].w}; } } while (0)
    ATT_LOAD(0);
    int qrow = q0 + qrel; unsigned slot = 0u; bool rowok = true;
    if (MODE == 1) { rowok = qrel < nvalid; const unsigned e = rowok ? *(const AGAS unsigned*)(lst + qrel) : 0u; qrow = (int)(e >> 2); slot = e & 3u; }
    const bool wave_ok = MODE == 1 ? (wid * 32 < nvalid) : true;
    bf16x8 qr[ND];
    { const bf16_t* qp = Q + (size_t)qrow * ldq + 8 * hi;
#pragma unroll
      for (int d0 = 0; d0 < ND; ++d0) qr[d0] = *(const AGAS bf16x8*)(qp + 16 * d0); }
    f32x16 o[4];
#pragma unroll
    for (int i = 0; i < 4; ++i)
#pragma unroll
        for (int r = 0; r < 16; ++r) o[i][r] = 0.f;
    float mrun = 0.f, lrun = 0.f; bool first = true;
    const float NINF = -__builtin_inff();

    ATT_STORE(0, 0);
    __syncthreads();
    const bool lag = wid >= 4; bool pend = false;
    int vcur = 0, vprev = 2;
    bf16x8 pf[4];
#pragma unroll
    for (int i = 0; i < 4; ++i) pf[i] = (bf16x8){0, 0, 0, 0, 0, 0, 0, 0};
    for (int t = 0; t < NT; ++t) {
        const int buf = t & 1;
        if (PROBE != 1 && PROBE != 4 && PROBE != 5 && PROBE != 6 && t + 1 < NT) ATT_LOAD(t + 1);
        if (pend) { pv_tile<PROBE == 6>(lds + VBASE + vprev * VBYTES + r32 * VROW + hi * 16, pf, o); pend = false; }
        const int jb = t - (NT - 4); const bool band = MODE == 1 ? false : jb >= 0;
        const bool active = PROBE == 2 ? false : (band ? (64 * jb <= 32 * wid + 31) : wave_ok);
        if (active) {
            f32x16 p0, p1;
#pragma unroll
            for (int r = 0; r < 16; ++r) { p0[r] = 0.f; p1[r] = 0.f; }
            qk_tile<DQK, PROBE == 6>(lds + buf * KBYTES + r32 * KROW + hi * 16, qr, p0, p1);
            if (band) { const int kvb = 64 * jb + 4 * hi;
#pragma unroll
                for (int r = 0; r < 16; ++r) { const int kv = kvb + (r & 3) + 8 * (r >> 2); if (kv > qrel) p0[r] = NINF; if (kv + 32 > qrel) p1[r] = NINF; } }
            if (PROBE != 4 && PROBE != 6) {
            float mxa = __builtin_fmaxf(__builtin_fmaxf(p0[0], p0[1]), p0[2]), mxb = __builtin_fmaxf(__builtin_fmaxf(p1[0], p1[1]), p1[2]);
            mxa = __builtin_fmaxf(__builtin_fmaxf(mxa, p0[3]), p1[3]);
#pragma unroll
            for (int r = 4; r < 16; r += 2) { mxa = __builtin_fmaxf(__builtin_fmaxf(mxa, p0[r]), p0[r + 1]); mxb = __builtin_fmaxf(__builtin_fmaxf(mxb, p1[r]), p1[r + 1]); }
            float mx = __builtin_fmaxf(mxa, mxb);
            const bool need = first ? (__builtin_fabsf(mx) > 16.0f) : (mx > mrun + 16.0f);
            if (__any(need)) {
                { auto rr = __builtin_amdgcn_permlane32_swap(__float_as_uint(mx), __float_as_uint(mx), false, false); mx = __builtin_fmaxf(__uint_as_float(rr[0]), __uint_as_float(rr[1])); }
                const float mnew = first ? mx : fmaxf(mrun, mx); const float al = __builtin_amdgcn_exp2f(mrun - mnew); lrun *= al;
                if (!first) {
#pragma unroll
                for (int i = 0; i < 4; ++i)
#pragma unroll
                    for (int r = 0; r < 16; ++r) o[i][r] *= al; }
                mrun = mnew; }
            first = false;
            float ps = 0.f;
            if (__all(mrun == 0.0f)) {
#pragma unroll
                for (int r = 0; r < 16; ++r) { p0[r] = __builtin_amdgcn_exp2f(p0[r]); p1[r] = __builtin_amdgcn_exp2f(p1[r]); ps += p0[r] + p1[r]; }
            } else {
#pragma unroll
                for (int r = 0; r < 16; ++r) { p0[r] = __builtin_amdgcn_exp2f(p0[r] - mrun); p1[r] = __builtin_amdgcn_exp2f(p1[r] - mrun); ps += p0[r] + p1[r]; }
            }
            lrun += ps;
            }
            { u32x4 w;
              w = (u32x4){cvtpk(p0[0], p0[1]), cvtpk(p0[2], p0[3]), cvtpk(p0[4], p0[5]), cvtpk(p0[6], p0[7])}; pf[0] = __builtin_bit_cast(bf16x8, w);
              w = (u32x4){cvtpk(p0[8], p0[9]), cvtpk(p0[10], p0[11]), cvtpk(p0[12], p0[13]), cvtpk(p0[14], p0[15])}; pf[1] = __builtin_bit_cast(bf16x8, w);
              w = (u32x4){cvtpk(p1[0], p1[1]), cvtpk(p1[2], p1[3]), cvtpk(p1[4], p1[5]), cvtpk(p1[6], p1[7])}; pf[2] = __builtin_bit_cast(bf16x8, w);
              w = (u32x4){cvtpk(p1[8], p1[9]), cvtpk(p1[10], p1[11]), cvtpk(p1[12], p1[13]), cvtpk(p1[14], p1[15])}; pf[3] = __builtin_bit_cast(bf16x8, w); }
            if (PROBE == 5) { o[0][0] += __builtin_bit_cast(float, (int)pf[0][0] | ((int)pf[3][1] << 16)); } else if (lag) pend = true; else pv_tile<PROBE == 6>(lds + VBASE + vcur * VBYTES + r32 * VROW + hi * 16, pf, o);
        }
        const int vnext = vcur == 2 ? 0 : vcur + 1;
        if (PROBE != 1 && PROBE != 4 && PROBE != 5 && PROBE != 6 && t + 1 < NT) ATT_STORE(buf ^ 1, vnext);
        if (PROBE != 3) __syncthreads();
        vprev = vcur; vcur = vnext;
    }
    if (pend) pv_tile<PROBE == 6>(lds + VBASE + vprev * VBYTES + r32 * VROW + hi * 16, pf, o);
    __syncthreads();
#undef ATT_LOAD
#undef ATT_STORE
    const float lt = lrun + __shfl_xor(lrun, 32);
    if (MODE == 0) {
        const float inv = 1.0f / lt;
        bf16_t* op = O + (size_t)qrow * 2048 + 4 * hi;
#pragma unroll
        for (int i = 0; i < 4; ++i)
#pragma unroll
            for (int g = 0; g < 4; ++g) { const u32x2 w = (u32x2){cvtpk(o[i][4 * g] * inv, o[i][4 * g + 1] * inv), cvtpk(o[i][4 * g + 2] * inv, o[i][4 * g + 3] * inv)}; *(AGAS u32x2*)(op + 32 * i + 8 * g) = w; }
    } else if (MODE == 1) {
        if (rowok) {
            const float inv = 1.0f / lt;
            const size_t pr = ((size_t)slot * SEQ + qrow) * 8 + h;
            bf16_t* op = part + pr * 128 + 64 * hi;
#pragma unroll
            for (int i = 0; i < 4; ++i)
#pragma unroll
                for (int g2 = 0; g2 < 2; ++g2) { const int r0 = 8 * g2;
                    const u32x4 w = (u32x4){cvtpk(o[i][r0] * inv, o[i][r0 + 1] * inv), cvtpk(o[i][r0 + 2] * inv, o[i][r0 + 3] * inv), cvtpk(o[i][r0 + 4] * inv, o[i][r0 + 5] * inv), cvtpk(o[i][r0 + 6] * inv, o[i][r0 + 7] * inv)};
                    *(AGAS u32x4*)(op + 16 * i + 8 * g2) = w; }
            if (hi == 0) { *(AGAS float*)(ml + pr * 2) = mrun; *(AGAS float*)(ml + pr * 2 + 1) = lt; }
        }
    } else {
        const int ns = qb < 3 ? qb : 3;
        float ms0 = -1e30f, ms1 = -1e30f, ms2 = -1e30f, ls0 = 0.f, ls1 = 0.f, ls2 = 0.f;
        if (ns > 0) { const size_t pr = ((size_t)0 * SEQ + qrow) * 8 + h; ms0 = *(const AGAS float*)(ml + pr * 2); ls0 = *(const AGAS float*)(ml + pr * 2 + 1); }
        if (ns > 1) { const size_t pr = ((size_t)1 * SEQ + qrow) * 8 + h; ms1 = *(const AGAS float*)(ml + pr * 2); ls1 = *(const AGAS float*)(ml + pr * 2 + 1); }
        if (ns > 2) { const size_t pr = ((size_t)2 * SEQ + qrow) * 8 + h; ms2 = *(const AGAS float*)(ml + pr * 2); ls2 = *(const AGAS float*)(ml + pr * 2 + 1); }
        const float M = fmaxf(fmaxf(mrun, ms0), fmaxf(ms1, ms2));
        const float w0 = __builtin_amdgcn_exp2f(mrun - M), w1 = ls0 * __builtin_amdgcn_exp2f(ms0 - M), w2 = ls1 * __builtin_amdgcn_exp2f(ms1 - M), w3 = ls2 * __builtin_amdgcn_exp2f(ms2 - M);
        const float inv = 1.0f / (w0 * lt + w1 + w2 + w3);
#pragma unroll
        for (int i = 0; i < 4; ++i)
#pragma unroll
            for (int r = 0; r < 16; ++r) o[i][r] *= w0;
#define MERGE_SLOT(sidx, wgt) do { const bf16_t* pp = part + (((size_t)(sidx) * SEQ + qrow) * 8 + h) * 128 + 64 * hi; \
            _Pragma("unroll") for (int i = 0; i < 4; ++i) _Pragma("unroll") for (int g2 = 0; g2 < 2; ++g2) { const u32x4 w = *(const AGAS u32x4*)(pp + 16 * i + 8 * g2); const int r0 = 8 * g2; \
                o[i][r0] += (wgt) * __uint_as_float(w.x << 16); o[i][r0 + 1] += (wgt) * __uint_as_float(w.x & 0xffff0000u); o[i][r0 + 2] += (wgt) * __uint_as_float(w.y << 16); o[i][r0 + 3] += (wgt) * __uint_as_float(w.y & 0xffff0000u); \
                o[i][r0 + 4] += (wgt) * __uint_as_float(w.z << 16); o[i][r0 + 5] += (wgt) * __uint_as_float(w.z & 0xffff0000u); o[i][r0 + 6] += (wgt) * __uint_as_float(w.w << 16); o[i][r0 + 7] += (wgt) * __uint_as_float(w.w & 0xffff0000u); } } while (0)
        if (ns > 0) MERGE_SLOT(0, w1);
        if (ns > 1) MERGE_SLOT(1, w2);
        if (ns > 2) MERGE_SLOT(2, w3);
#undef MERGE_SLOT
        bf16_t* op = O + (size_t)qrow * 2048 + 4 * hi;
#pragma unroll
        for (int i = 0; i < 4; ++i)
#pragma unroll
            for (int g = 0; g < 4; ++g) { const u32x2 w = (u32x2){cvtpk(o[i][4 * g] * inv, o[i][4 * g + 1] * inv), cvtpk(o[i][4 * g + 2] * inv, o[i][4 * g + 3] * inv)}; *(AGAS u32x2*)(op + 32 * i + 8 * g) = w; }
    }
}
}
#include <hip/hip_cooperative_groups.h>
namespace cg = cooperative_groups;
#define LAS __attribute__((address_space(3)))
typedef unsigned short bf16;
typedef unsigned v4u __attribute__((ext_vector_type(4)));
typedef unsigned v2u __attribute__((ext_vector_type(2)));
typedef float f32x4 __attribute__((ext_vector_type(4)));
constexpr int S = 16384, DM = 2048, DFF = 5632, INC = 5184;
constexpr size_t MiB = 1u << 20;
constexpr size_t WS_SSQC = 0, WS_SSQ1 = 64 * 1024, WS_SSQ2 = 128 * 1024, WS_SSQ3 = 192 * 1024, WS_KMEAN = 256 * 1024, WS_CNT = 384 * 1024, WS_PCNT = 392 * 1024  ;
constexpr size_t WS_LIST = 192 * MiB  , WS_PART = 256 * MiB  , WS_ML = 352 * MiB  ;
constexpr size_t WS_WIN = 2 * MiB, WS_WVMB = 19 * MiB, WS_WK = 23 * MiB, WS_WV = 24 * MiB, WS_WO = 25 * MiB, WS_WGU = 33 * MiB, WS_WD = 77 * MiB, WS_WPG = 99 * MiB, WS_WPE = 107 * MiB;
constexpr size_t WS_PB = 108 * MiB, WS_T128 = 116 * MiB, WS_T64 = 124 * MiB, WS_A0 = 128 * MiB, WS_HB = 192 * MiB;
constexpr size_t WS_QMLA = 256 * MiB, WS_KMLA = 304 * MiB, WS_VTMLA = 352 * MiB, WS_CKV = 384 * MiB, WS_QMB = 400 * MiB, WS_KMB = 432 * MiB, WS_VTMB = 464 * MiB, WS_FF = 256 * MiB, WS_END = 496 * MiB;
constexpr int NWIN = 4352;
constexpr int LDS_BYTES = 133120, MISC_OFF = 131072;
constexpr size_t WS_BAR = 512 * 1024, WS_DUMMY = 448 * 1024;

__device__ const float INV128[64] = {1.000000000e+00f, 8.659643531e-01f, 7.498942614e-01f, 6.493816376e-01f, 5.623413324e-01f, 4.869675338e-01f, 4.216965139e-01f, 3.651741147e-01f, 3.162277639e-01f, 2.738419771e-01f, 2.371373773e-01f, 2.053525001e-01f, 1.778279394e-01f, 1.539926529e-01f, 1.333521307e-01f, 1.154782027e-01f, 1.000000015e-01f, 8.659642935e-02f, 7.498941571e-02f, 6.493816525e-02f, 5.623413250e-02f, 4.869675264e-02f, 4.216965288e-02f, 3.651741147e-02f, 3.162277490e-02f, 2.738419734e-02f, 2.371373773e-02f, 2.053525113e-02f, 1.778279431e-02f, 1.539926510e-02f, 1.333521493e-02f, 1.154782064e-02f, 9.999999776e-03f, 8.659643121e-03f, 7.498941850e-03f, 6.493816152e-03f, 5.623413250e-03f, 4.869675264e-03f, 4.216964822e-03f, 3.651741194e-03f, 3.162277630e-03f, 2.738419687e-03f, 2.371373586e-03f, 2.053524833e-03f, 1.778279431e-03f, 1.539926510e-03f, 1.333521446e-03f, 1.154781901e-03f, 1.000000047e-03f, 8.659643354e-04f, 7.498942432e-04f, 6.493816618e-04f, 5.623413017e-04f, 4.869675322e-04f, 4.216965172e-04f, 3.651741426e-04f, 3.162277571e-04f, 2.738419571e-04f, 2.371373703e-04f, 2.053525095e-04f, 1.778279402e-04f, 1.539926452e-04f, 1.333521504e-04f, 1.154782003e-04f};
__device__ const float INV64[32] = {1.000000000e+00f, 7.498942614e-01f, 5.623413324e-01f, 4.216965139e-01f, 3.162277639e-01f, 2.371373773e-01f, 1.778279394e-01f, 1.333521307e-01f, 1.000000015e-01f, 7.498941571e-02f, 5.623413250e-02f, 4.216965288e-02f, 3.162277490e-02f, 2.371373773e-02f, 1.778279431e-02f, 1.333521493e-02f, 9.999999776e-03f, 7.498941850e-03f, 5.623413250e-03f, 4.216964822e-03f, 3.162277630e-03f, 2.371373586e-03f, 1.778279431e-03f, 1.333521446e-03f, 1.000000047e-03f, 7.498942432e-04f, 5.623413017e-04f, 4.216965172e-04f, 3.162277571e-04f, 2.371373703e-04f, 1.778279402e-04f, 1.333521504e-04f};

__device__ __forceinline__ unsigned f2bf(float f) { unsigned u = __builtin_bit_cast(unsigned, f); return (u + 0x7fffu + ((u >> 16) & 1u)) >> 16; }
__device__ __forceinline__ unsigned pk2(float lo, float hi) { return f2bf(lo) | (f2bf(hi) << 16); }
__device__ __forceinline__ float wave_sum(float v) {
#pragma unroll
    for (int o = 1; o < 64; o <<= 1) v += __shfl_xor(v, o);
    return v;
}
__device__ __forceinline__ void sincos_acc(float ang, float& c, float& s) {
    double t = (double)ang * 0.15915494309189535; t -= rint(t); const double r = t * 6.283185307179586, r2 = r * r;
    double sp = 1.0, cp = 1.0;
#pragma unroll
    for (int k = 13; k >= 1; --k) { sp = 1.0 - sp * r2 * (1.0 / (double)((2 * k) * (2 * k + 1))); cp = 1.0 - cp * r2 * (1.0 / (double)((2 * k - 1) * (2 * k))); }
    s = (float)(r * sp); c = (float)cp;
}
__device__ __forceinline__ void transpose_item(const float* W, int ldw, int col0, int K, int k0, bf16* WT, int dstrow0, const float* gain, bool zero, LAS float* scr, int lane) {
    f32x4 v[8];
    const int kr = lane >> 3, n4 = 4 * (lane & 7);
#pragma unroll
    for (int i = 0; i < 8; ++i) v[i] = zero ? (f32x4){0.f, 0.f, 0.f, 0.f} : *(const f32x4*)(W + (size_t)(k0 + kr + 8 * i) * ldw + col0 + n4);
    if (gain) {
#pragma unroll
        for (int i = 0; i < 8; ++i) v[i] = v[i] * gain[k0 + kr + 8 * i]; }
#pragma unroll
    for (int i = 0; i < 8; ++i) { LAS float* d = scr + (kr + 8 * i) * 33 + n4; d[0] = v[i].x; d[1] = v[i].y; d[2] = v[i].z; d[3] = v[i].w; }
    asm volatile("s_waitcnt lgkmcnt(0)" ::: "memory");
    const int c = lane & 7;
#pragma unroll
    for (int j = 0; j < 4; ++j) { const int n = (lane >> 3) + 8 * j; const LAS float* s = scr + (8 * c) * 33 + n;
        v4u o; o.x = pk2(s[0 * 33], s[1 * 33]); o.y = pk2(s[2 * 33], s[3 * 33]); o.z = pk2(s[4 * 33], s[5 * 33]); o.w = pk2(s[6 * 33], s[7 * 33]);
        *(v4u*)(WT + (size_t)(dstrow0 + n) * K + k0 + 8 * c) = o; }
    asm volatile("s_waitcnt lgkmcnt(0)" ::: "memory");
}
__device__ __forceinline__ int win_src(int g) {
    const int t = g >> 3, cgp = g & 7;
    if (t < 4) return (2 * t + (cgp >> 2)) * 192 + (cgp & 3) * 32;
    if (t < 6) return (4 * (t - 4) + (cgp & 3)) * 192 + 128 + 32 * (cgp >> 2);
    if (t < 8) return 1536 + 256 * (t - 6) + 32 * cgp;
    if (t < 16) { const int base = t < 12 ? 2112 : 3136, uu = t < 12 ? t - 8 : t - 12, half = cgp >> 2, cc = (cgp & 3) * 32; return base + (2 * uu + (cc >> 6)) * 128 + 64 * half + (cc & 63); }
    return (cgp & 3) == 0 ? 2048 + 32 * (cgp >> 2) : -1;
}

typedef __attribute__((address_space(1))) unsigned gu32;
#define XB_TMO      128
#define XB_XCNT(j)  (256  + 64 * (j))
#define XB_XSUB(j)  (1280 + 64 * (j))
#define XB_XGEN(j)  (2304 + 64 * (j))
#define XB_TOP      3328
#define XB_TOPGEN   3392
#define XCD_BAR_WORDS 3456
#define XB_SPIN_CAP (1u << 18)

__device__ __forceinline__ unsigned xb_ld(unsigned* p)              { return __hip_atomic_load(p, __ATOMIC_RELAXED, __HIP_MEMORY_SCOPE_AGENT); }
__device__ __forceinline__ unsigned xb_add(unsigned* p, unsigned v) { return __hip_atomic_fetch_add(p, v, __ATOMIC_RELAXED, __HIP_MEMORY_SCOPE_AGENT); }
__device__ __forceinline__ unsigned xb_xcc_id() { return (unsigned)__builtin_amdgcn_s_getreg((3 << 11) | 20) & 0xFu; }
#define XB_SPIN(cond, bar) do { unsigned _sp = 0; while (cond) { __builtin_amdgcn_s_sleep(1); \
    if ((++_sp & 255u) == 0u) { if (xb_ld(&(bar)[XB_TMO])) break; if (_sp > XB_SPIN_CAP) { atomicAdd(&(bar)[XB_TMO], 1u); break; } } } } while (0)

struct XcdBarrier {
    unsigned* bar; unsigned x;
    volatile LAS unsigned* st;
};

__device__ __forceinline__ XcdBarrier xcd_barrier_post(unsigned* bar, volatile LAS unsigned* st) {
    XcdBarrier b; b.bar = bar; b.x = xb_xcc_id(); b.st = st;
    if (threadIdx.x == 0) (void)xb_add(&bar[XB_XCNT(b.x)], 1u);
    return b;
}
__device__ __forceinline__ void xcd_barrier_complete(unsigned* bar, unsigned x, unsigned& nloc, unsigned& nx) {
    const unsigned G = gridDim.x * gridDim.y * gridDim.z;
    unsigned sum, cnt, mine, sp = 0u;
    for (;;) {
        sum = 0u; cnt = 0u; mine = 0u;
#pragma unroll
        for (unsigned j = 0; j < 16; ++j) { const unsigned c = xb_ld(&bar[XB_XCNT(j)]); sum += c; cnt += (c > 0u) ? 1u : 0u; mine = (j == x) ? c : mine; }
        if (sum == G) break;
        __builtin_amdgcn_s_sleep(1);
        if ((++sp & 255u) == 0u) { if (xb_ld(&bar[XB_TMO])) break; if (sp > XB_SPIN_CAP) { atomicAdd(&bar[XB_TMO], 1u); break; } }
    }
    nloc = mine > 0u ? mine : 1u; nx = cnt > 0u ? cnt : 1u;
}

__device__ __forceinline__ void xcd_barrier(const XcdBarrier& b) {
    asm volatile("s_waitcnt vmcnt(0)" ::: "memory");
    __syncthreads();
    if (threadIdx.x == 0) {
        unsigned* bar = b.bar;
        __builtin_amdgcn_s_waitcnt(0);
        unsigned nloc = b.st[0], nx = b.st[1];
        if (nloc == 0u) { xcd_barrier_complete(bar, b.x, nloc, nx); b.st[0] = nloc; b.st[1] = nx; }
        const unsigned old = xb_add(&bar[XB_XSUB(b.x)], 1u);
        const unsigned gen = old / nloc;
        if (old + 1u == (gen + 1u) * nloc) {
            __builtin_amdgcn_fence(__ATOMIC_RELEASE, "agent");
            asm volatile("s_waitcnt vmcnt(0)" ::: "memory");
            const unsigned og = xb_add(&bar[XB_TOP], 1u);
            const unsigned tg = og / nx;
            if (og + 1u == (tg + 1u) * nx) xb_add(&bar[XB_TOPGEN], 1u);
            else XB_SPIN(xb_ld(&bar[XB_TOPGEN]) == tg, bar);
            __builtin_amdgcn_fence(__ATOMIC_ACQUIRE, "agent");
            xb_add(&bar[XB_XGEN(b.x)], 1u);
            asm volatile("s_waitcnt vmcnt(0)" ::: "memory");
        } else {
            XB_SPIN(xb_ld(&bar[XB_XGEN(b.x)]) == gen, bar);
            __builtin_amdgcn_fence(__ATOMIC_ACQUIRE, "agent");
            asm volatile("s_waitcnt vmcnt(0)" ::: "memory");
        }
    }
    __syncthreads();
}

struct Args { const float* in[16]; float* out; unsigned char* ws; int ph_lo, ph_hi; };
enum { I_X = 0, I_P, I_POS, I_ANORM, I_WIN, I_KVNORM, I_WUKV, I_WO, I_FNORM, I_WG, I_WU, I_WD, I_PNORM, I_WPG, I_WPE, I_FINAL };

template <class Epi> __device__ __forceinline__ void run_gemm(LAS unsigned char* lds, const bf16* A, const bf16* Bt, int M, int N, int K, const Epi& E) {
    asm volatile("" : "+s"(M), "+s"(N), "+s"(K));
    pg8::Gemm g{A, Bt, M, N, K}; pg8::StaticOrder So; So.init(M, N, (int)gridDim.x, (int)blockIdx.x);
    pg8::gemm_phase<Epi, pg8::StaticOrder, true, true>(lds, g, So, E);
}

template <class E0, class E1> __device__ __forceinline__ void run_gemm2(LAS unsigned char* lds, const bf16* A0_, const bf16* B0_, int M0, int N0, const bf16* A1_, const bf16* B1_, int M1, int N1, int K, const E0& e0, const E1& e1) {
    asm volatile("" : "+s"(M0), "+s"(N0), "+s"(M1), "+s"(N1), "+s"(K));
    pg8::Gemm g{A0_, B0_, M0, N0, K}; pg8::DualOrder So; So.init(M0, N0, M1, N1, (int)gridDim.x, (int)blockIdx.x, A1_, B1_);
    pg8::EpiDual<E0, E1> E{e0, e1};
    pg8::gemm_phase<pg8::EpiDual<E0, E1>, pg8::DualOrder, true, true>(lds, g, So, E);
}
template <class E0, class E1, class E2> __device__ __forceinline__ void run_gemm3(LAS unsigned char* lds, const bf16* A0_, const bf16* B0_, int M0, int N0, int K0, const bf16* A1_, const bf16* B1_, int M1, int N1, int K1,
                                                                               const bf16* A2_, const bf16* B2_, int M2, int N2, int K2, const E0& e0, const E1& e1, const E2& e2) {
    asm volatile("" : "+s"(M0), "+s"(N0), "+s"(K0), "+s"(M1), "+s"(N1), "+s"(K1), "+s"(M2), "+s"(N2), "+s"(K2));
    pg8::Gemm g{A0_, B0_, M0, N0, K0}; pg8::TriOrder So; So.init(M0, N0, M1, N1, M2, N2, (int)gridDim.x, (int)blockIdx.x, A1_, B1_, K1, A2_, B2_, K2);
    pg8::EpiTri<E0, E1, E2> E{e0, e1, e2};
    pg8::gemm_phase<pg8::EpiTri<E0, E1, E2>, pg8::TriOrder, true, true>(lds, g, So, E);
}
__global__ void __launch_bounds__(512) fwd(Args a) {
    extern __shared__ __attribute__((aligned(16))) unsigned char lds_raw[];
    LAS unsigned char* lds = (LAS unsigned char*)lds_raw;
    const int tid = threadIdx.x, lane = tid & 63, wave = __builtin_amdgcn_readfirstlane(tid >> 6);
    const int G = gridDim.x, bx = blockIdx.x;
    const int vcu = (G % 8 == 0) ? (bx % 8) * (G / 8) + bx / 8 : bx;
#define PTRS \
        unsigned char* ws = a.ws; asm volatile("" : "+s"(ws));     \
        float* ssqc = (float*)(ws + WS_SSQC); float* ssq1 = (float*)(ws + WS_SSQ1); float* ssq2 = (float*)(ws + WS_SSQ2); float* ssq3 = (float*)(ws + WS_SSQ3); bf16* kmean = (bf16*)(ws + WS_KMEAN); \
        bf16 *Win_t = (bf16*)(ws + WS_WIN), *Wvmb_t = (bf16*)(ws + WS_WVMB), *Wk_t = (bf16*)(ws + WS_WK), *Wv_t = (bf16*)(ws + WS_WV), *Wo_t = (bf16*)(ws + WS_WO), *Wgu_t = (bf16*)(ws + WS_WGU), *Wd_t = (bf16*)(ws + WS_WD), *Wpg_t = (bf16*)(ws + WS_WPG), *Wpe_t = (bf16*)(ws + WS_WPE); \
        bf16 *pb = (bf16*)(ws + WS_PB), *A0 = (bf16*)(ws + WS_A0), *hb = (bf16*)(ws + WS_HB), *qmla = (bf16*)(ws + WS_QMLA), *kmla = (bf16*)(ws + WS_KMLA), *vtmla = (bf16*)(ws + WS_VTMLA), *ckv = (bf16*)(ws + WS_CKV), \
             *qmb = (bf16*)(ws + WS_QMB), *kmb = (bf16*)(ws + WS_KMB), *vtmb = (bf16*)(ws + WS_VTMB), *ff = (bf16*)(ws + WS_FF); \
        float* tab128 = (float*)(ws + WS_T128); float* tab64 = (float*)(ws + WS_T64); unsigned* mcnt = (unsigned*)(ws + WS_CNT); unsigned* mlist = (unsigned*)(ws + WS_LIST); bf16* mpart = (bf16*)(ws + WS_PART); float* mml = (float*)(ws + WS_ML); \
        (void)mcnt; (void)mlist; (void)mpart; (void)mml; \
        (void)ssqc; (void)ssq1; (void)ssq2; (void)ssq3; (void)kmean; (void)Win_t; (void)Wvmb_t; (void)Wk_t; (void)Wv_t; (void)Wo_t; (void)Wgu_t; (void)Wd_t; (void)Wpg_t; (void)Wpe_t; (void)pb; (void)A0; (void)hb; (void)qmla; (void)kmla; (void)vtmla; (void)ckv; (void)qmb; (void)kmb; (void)vtmb; (void)ff; (void)tab128; (void)tab64;
    const int lo = a.ph_lo, hi = a.ph_hi;
    if (tid < 2) ((LAS unsigned*)(lds + MISC_OFF))[tid] = 0u;
    __syncthreads();
    XcdBarrier xbar = xcd_barrier_post((unsigned*)(a.ws + WS_BAR), (volatile LAS unsigned*)(lds + MISC_OFF));
#ifndef PH_MASK
#define PH_MASK 0x7ff
#endif
#define IN(k) (((PH_MASK >> (k)) & 1) && lo <= (k) && (k) < hi)
#define SEAM(k) do { if (IN(k) && IN((k) + 1)) { if (a.ph_lo < 0) cg::this_grid().sync();     \
        xcd_barrier(xbar); } } while (0)
    const int gw = vcu * 8 + wave, NGW = G * 8, gt = bx * 512 + tid, NGT = G * 512;

    if (IN(0)) { PTRS
#ifdef DUP_P0
      for (int dup_ = 0; dup_ < 2; ++dup_) {
#else
      {
#endif
        LAS float* scr = (LAS float*)(lds + wave * 16384);
        constexpr int C0 = (NWIN / 32) * 32, C1 = C0 + 32 * 32, C2 = C1 + 32 * 8, C3 = C2 + 32 * 8, C4 = C3 + 64 * 32, C5 = C4 + 352 * 32, C6 = C5 + 64 * 88, C7 = C6 + 64 * 32, C8 = C7 + 64 * 4;
        for (int it = gw; it < C8; it += NGW) {
            if (it < C0) { const int g = it % 136, kb = it / 136, src = win_src(g); transpose_item(a.in[I_WIN], INC, src < 0 ? 0 : src, 2048, 64 * kb, Win_t, 32 * g, nullptr, src < 0, scr, lane); }
            else if (it < C1) { const int r = it - C0, g = r % 32, kb = r / 32; transpose_item(a.in[I_WIN], INC, 4160 + 32 * g, 2048, 64 * kb, Wvmb_t, 32 * g, nullptr, false, scr, lane); }
            else if (it < C2) { const int r = it - C1, g = r % 32, kb = r / 32; transpose_item(a.in[I_WUKV], 2048, (g >> 2) * 256 + 32 * (g & 3), 512, 64 * kb, Wk_t, 32 * g, a.in[I_KVNORM], false, scr, lane); }
            else if (it < C3) { const int r = it - C2, g = r % 32, kb = r / 32; transpose_item(a.in[I_WUKV], 2048, (g >> 2) * 256 + 128 + 32 * (g & 3), 512, 64 * kb, Wv_t, 32 * g, a.in[I_KVNORM], false, scr, lane); }
            else if (it < C4) { const int r = it - C3, g = r % 64, kb = r / 64; transpose_item(a.in[I_WO], 2048, 32 * g, 2048, 64 * kb, Wo_t, 32 * g, nullptr, false, scr, lane); }
            else if (it < C5) { const int r = it - C4, g = r % 352, kb = r / 352, pn = g >> 3, bj = (g >> 2) & 1, cc = (g & 3) * 32; transpose_item(bj ? a.in[I_WU] : a.in[I_WG], DFF, 128 * pn + cc, 2048, 64 * kb, Wgu_t, 32 * g, a.in[I_FNORM], false, scr, lane); }
            else if (it < C6) { const int r = it - C5, g = r % 64, kb = r / 64; transpose_item(a.in[I_WD], 2048, 32 * g, DFF, 64 * kb, Wd_t, 32 * g, nullptr, false, scr, lane); }
            else if (it < C7) { const int r = it - C6, g = r % 64, kb = r / 64; transpose_item(a.in[I_WPG], 2048, 32 * g, 2048, 64 * kb, Wpg_t, 32 * g, a.in[I_PNORM], false, scr, lane); }
            else { const int r = it - C7, g = r % 64, kb = r / 64; transpose_item(a.in[I_WPE], 2048, 32 * g, 256, 64 * kb, Wpe_t, 32 * g, nullptr, false, scr, lane); }
        }
        { const float* gn = a.in[I_ANORM];
          for (int m = gw; m < S; m += NGW) { const f32x4* xr = (const f32x4*)(a.in[I_X] + (size_t)m * DM) + lane; f32x4 v[8]; float s = 0.f;
#pragma unroll
              for (int j = 0; j < 8; ++j) { v[j] = xr[64 * j]; s += (v[j].x * v[j].x + v[j].y * v[j].y) + (v[j].z * v[j].z + v[j].w * v[j].w); }
              const float rstd = 1.0f / sqrtf(wave_sum(s) * (1.0f / DM) + 1e-6f);
              v2u* o8 = (v2u*)(A0 + (size_t)m * DM) + lane;
#pragma unroll
              for (int j = 0; j < 8; ++j) { const f32x4 gg = ((const f32x4*)gn)[lane + 64 * j]; o8[64 * j] = (v2u){pk2(v[j].x * rstd * gg.x, v[j].y * rstd * gg.y), pk2(v[j].z * rstd * gg.z, v[j].w * rstd * gg.w)}; } } }
        for (int i = gt; i < S * 256 / 4; i += NGT) { const f32x4 v = ((const f32x4*)a.in[I_P])[i]; ((v2u*)pb)[i] = (v2u){pk2(v.x, v.y), pk2(v.z, v.w)}; }
        { const int* pos = (const int*)a.in[I_POS];
          for (int i = gt; i < S * 96; i += NGT) { const int row = i / 96, j = i % 96; const float pf = (float)pos[row]; float c, s;
              if (j < 64) { sincos_acc(pf * INV128[j], c, s); tab128[((size_t)row * 64 + j) * 2] = c; tab128[((size_t)row * 64 + j) * 2 + 1] = s; }
              else { sincos_acc(pf * INV64[j - 64], c, s); tab64[((size_t)row * 32 + (j - 64)) * 2] = c; tab64[((size_t)row * 32 + (j - 64)) * 2 + 1] = s; } } }
        for (int i = gt; i < 4 * S; i += NGT) ssqc[i] = 0.f;
        for (int i = gt; i < 512; i += NGT) mcnt[i] = 0u;
        for (int i = gt; i < 64 * 64; i += NGT) ((unsigned*)(ws + WS_PCNT))[i] = 0u;
      }
    }
    SEAM(0);
    if (IN(1)) { PTRS
        pg8::EpiProj E{qmla, kmla, ckv, qmb, kmb, ssqc, tab128, tab64};
        pg8::EpiT<false> Et{vtmb, S, nullptr, 0.f};
        pg8::EpiP Ep{(bf16*)a.out};
        run_gemm3(lds, A0, Win_t, S, NWIN, 2048, Wvmb_t, A0, 1024, S, 2048, pb, Wpe_t, S, 2048, 256, E, Et, Ep);
    }
    SEAM(1);
    if (IN(2)) { PTRS
        pg8::EpiKnope Ek{kmla, ssqc};
        pg8::EpiT<true> Et{vtmla, S, ssqc, 1.0f / 512.0f};
        run_gemm2(lds, ckv, Wk_t, S, 1024, Wv_t, ckv, 1024, S, 512, Ek, Et);
#ifdef DUP_P2
        run_gemm2(lds, ckv, Wk_t, S, 1024, Wv_t, ckv, 1024, S, 512, Ek, Et);
#endif
#ifdef DUP_KMEAN
      for (int dup_ = 0; dup_ < 2; ++dup_)
#endif
      {
        for (int i = gt; i < 64 * 1024; i += NGT) { const int n = i >> 10, col = i & 1023; const bf16* kp = kmb + (size_t)(256 * n) * 1024 + col; float s = 0.f;
            for (int r = 0; r < 256; ++r) s += pg8::bf2f(kp[(size_t)r * 1024]);
            kmean[((col >> 7) * 64 + n) * 128 + (col & 127)] = (bf16)f2bf(s * (1.0f / 256.0f)); }
      }
    }
    SEAM(2);
    if (IN(3)) { PTRS
        for (int v = vcu; v < 256; v += G) { const int h = v >> 5, s = v & 31;
#pragma unroll 1
            for (int i = 0; i < 2; ++i) { const int qb = i == 0 ? 63 - s : s;
                att::gate_unit(lds, qmb + h * 128, kmean + h * 64 * 128, qb, mcnt + h * 64, mlist + (size_t)h * 64 * S); }
#ifdef PROBE_MLA
#pragma unroll 1
            for (int i = 0; i < 2; ++i) { const int qb = i == 0 ? 63 - s : s;
                att::unit<192, 0, PROBE_MLA>(lds, qmla + h * 192, 1536, kmla + h * 192, 1536, vtmla + (size_t)h * 128 * S, A0 + h * 128, qb, nullptr, 0, nullptr, nullptr, h); }
#endif
#pragma unroll 1
            for (int i = 0; i < 2; ++i) { const int qb = i == 0 ? 63 - s : s;
                att::unit<192, 0>(lds, qmla + h * 192, 1536, kmla + h * 192, 1536, vtmla + (size_t)h * 128 * S, A0 + h * 128, qb, nullptr, 0, nullptr, nullptr, h); } }
    }
    SEAM(3);
    if (IN(4)) { PTRS
        LAS unsigned* pre = (LAS unsigned*)(lds + att::ATT_LDS);
        LAS unsigned* cntl = pre + 512;
        { const unsigned c = mcnt[tid]; cntl[tid] = c; unsigned vsum = (c + 255u) >> 8; pre[tid] = vsum; __syncthreads();
          for (int off = 1; off < 512; off <<= 1) { const unsigned add = tid >= off ? pre[tid - off] : 0u; __syncthreads(); vsum += add; pre[tid] = vsum; __syncthreads(); } }
        const int total = (int)pre[511];
#ifdef DUP_P4
      for (int dup_ = 0; dup_ < 2; ++dup_)
#endif
#pragma unroll 1
        for (int g = vcu; g < total; g += G) {
            int lo_ = 0, hi_ = 511;
            while (lo_ < hi_) { const int mid = (lo_ + hi_) >> 1; if ((int)pre[mid] > g) hi_ = mid; else lo_ = mid + 1; }
            const int li = __builtin_amdgcn_readfirstlane(lo_), c = g - (li ? (int)pre[li - 1] : 0), h = li >> 6, n = li & 63;
            const int cn = (int)cntl[li] - 256 * c, nvalid = cn < 256 ? cn : 256;
            att::unit<128, 1>(lds, qmb + h * 128, 1024, kmb + h * 128, 1024, vtmb + (size_t)h * 128 * S, nullptr, n, mlist + ((size_t)li * S + 256 * c), nvalid, mpart, mml, h);
        }
    }
    SEAM(4);
    if (IN(5)) { PTRS
        for (int v = vcu; v < 256; v += G) { const int h = v >> 5, s = v & 31;
#ifdef DUP_P5
#pragma unroll 1
            for (int i = 0; i < 4; ++i) { const int qb = (i & 1) == 0 ? 63 - s : s;
#else
#pragma unroll 1
            for (int i = 0; i < 2; ++i) { const int qb = i == 0 ? 63 - s : s;
#endif
                att::unit<128, 2>(lds, qmb + h * 128, 1024, kmb + h * 128, 1024, vtmb + (size_t)h * 128 * S, A0 + 1024 + h * 128, qb, nullptr, 0, mpart, mml, h); } }
    }
    SEAM(5);
#ifdef DUP_SYNC
    for (int dup_ = 0; dup_ < 10; ++dup_) xcd_barrier(xbar);
#endif
    if (IN(6)) { PTRS
#ifdef DUP_WO_NOEPI
        { pg8::EpiNone En{(float*)(ws + WS_DUMMY)}; run_gemm(lds, A0, Wo_t, S, 2048, 2048, En); }
#endif
#ifdef DUP_WO
        { pg8::EpiRes<true> Ed{a.in[I_X], hb, (float*)(ws + WS_DUMMY)}; run_gemm(lds, A0, Wo_t, S, 2048, 2048, Ed); }
#endif
        pg8::EpiRes<true> E{a.in[I_X], hb, ssq1}; run_gemm(lds, A0, Wo_t, S, 2048, 2048, E); }
    SEAM(6);
    if (IN(7)) { PTRS
#ifndef NO_SWI
        pg8::EpiSwiglu E{ff, ssq1}; run_gemm(lds, hb, Wgu_t, S, 2 * DFF, 2048, E);
#ifdef DUP_SWI
        run_gemm(lds, hb, Wgu_t, S, 2 * DFF, 2048, E);
#endif
#endif
    }
    SEAM(7);
    if (IN(8)) { PTRS pg8::EpiRes<false> E{hb, hb, ssq2}; run_gemm(lds, ff, Wd_t, S, 2048, DFF, E); }
    SEAM(8);
#ifndef FUSED_FINAL
#define FUSED_FINAL 1
#endif
    const bool fusedfin = FUSED_FINAL && (G == 256) && IN(9) && IN(10);
    if (IN(9)) { PTRS
        if (fusedfin) {
            int M_ = S, N_ = 2048, K_ = 2048; asm volatile("" : "+s"(M_), "+s"(N_), "+s"(K_));
            pg8::Gemm g{hb, Wpg_t, M_, N_, K_}; pg8::PanelOrder So{(int)blockIdx.x};
            pg8::EpiPleFused E{hb, (const bf16*)a.out, ssq2, ssq3, (unsigned*)(ws + WS_PCNT), a.out, a.in[I_FINAL]};
            pg8::gemm_phase<pg8::EpiPleFused, pg8::PanelOrder, true, true>(lds, g, So, E);
        } else { pg8::EpiPle E{hb, ff  , (const bf16*)a.out, ssq2, ssq3}; run_gemm(lds, hb, Wpg_t, S, 2048, 2048, E); }
    }
    if (!fusedfin) {
    SEAM(9);
    if (IN(10)) { PTRS const float* gn = a.in[I_FINAL];
        for (int m = gw; m < S; m += NGW) { const float r = 1.0f / sqrtf(ssq3[m] * (1.0f / DM) + 1e-6f); const v4u* xr = (const v4u*)(ff + (size_t)m * DM) + lane; f32x4* yr = (f32x4*)(a.out + (size_t)m * DM) + 2 * lane;
#pragma unroll
            for (int j = 0; j < 4; ++j) { const v4u w = xr[64 * j]; const f32x4 g0 = ((const f32x4*)gn)[2 * lane + 128 * j], g1 = ((const f32x4*)gn)[2 * lane + 128 * j + 1];
                f32x4 lo4 = (f32x4){__uint_as_float(w.x << 16), __uint_as_float(w.x & 0xffff0000u), __uint_as_float(w.y << 16), __uint_as_float(w.y & 0xffff0000u)};
                f32x4 hi4 = (f32x4){__uint_as_float(w.z << 16), __uint_as_float(w.z & 0xffff0000u), __uint_as_float(w.w << 16), __uint_as_float(w.w & 0xffff0000u)};
                yr[128 * j] = lo4 * r * g0; yr[128 * j + 1] = hi4 * r * g1; } } }
    }
#undef IN
#undef SEAM
}

#ifndef N_LAUNCH_MODE
#define N_LAUNCH_MODE 1
#endif
extern "C" void kernel_launch(void* const* d_in, const int* in_sizes, int n_in, void* d_out, int out_size, void* d_ws, size_t ws_size, hipStream_t stream) {
    static int grid = 0;
    if (grid == 0) {
        if (n_in != 16 || out_size != S * DM || ws_size < WS_END) { fprintf(stderr, "kernel_launch: unexpected shapes (n_in %d out %d ws %zu)\n", n_in, out_size, ws_size); grid = -1; return; }
        int dev = 0, cus = 0, per_cu = 0;
        hipGetDevice(&dev); hipDeviceGetAttribute(&cus, hipDeviceAttributeMultiprocessorCount, dev);
        if (hipFuncSetAttribute((const void*)fwd, hipFuncAttributeMaxDynamicSharedMemorySize, LDS_BYTES) != hipSuccess) { fprintf(stderr, "kernel_launch: hipFuncSetAttribute failed\n"); grid = -1; return; }
        if (hipOccupancyMaxActiveBlocksPerMultiprocessor(&per_cu, (const void*)fwd, 512, LDS_BYTES) != hipSuccess || per_cu < 1) { fprintf(stderr, "kernel_launch: occupancy query says %d\n", per_cu); per_cu = 1; }
        (void)hipGetLastError();
        grid = cus;
    }
    if (grid < 0) return;
    Args a{};
    for (int i = 0; i < 16; ++i) a.in[i] = (const float*)d_in[i];
    a.out = (float*)d_out; a.ws = (unsigned char*)d_ws;
    if (N_LAUNCH_MODE == 1) {
        (void)hipMemsetAsync((unsigned char*)d_ws + WS_BAR, 0, XCD_BAR_WORDS * 4, stream);
        a.ph_lo = 0; a.ph_hi = 11; void* args[] = {&a};
        hipError_t e = hipLaunchCooperativeKernel((const void*)fwd, dim3(grid), dim3(512), args, LDS_BYTES, stream);
        if (e != hipSuccess) fprintf(stderr, "cooperative launch failed: %s (grid %d)\n", hipGetErrorString(e), grid);
    } else {
        for (int p = 0; p < 11; ++p) { a.ph_lo = p; a.ph_hi = p + 1; hipLaunchKernelGGL(fwd, dim3(grid), dim3(512), LDS_BYTES, stream, a); }
    }
}
```
